# Optimizing an MI355X kernel written in HIP

```python
import jax, jax.numpy as jnp
from jax import lax
import numpy as np

D_MODEL = 1024
BATCH = 1
SEQ = 16384
DEPTH = 4

N_EVEN = (DEPTH + 1) // 2
N_ODD = DEPTH // 2
D_FF = 2816

POOL_WINDOWS = (2, 4, 8, 16)
POOL_GROUPS = len(POOL_WINDOWS)
POOL_DIM = D_MODEL // 2
POOL_GROUP_DIM = POOL_DIM // POOL_GROUPS

MLA_HEADS = 8
QK_NOPE_DIM = D_MODEL // 16
QK_ROPE_DIM = D_MODEL // 32
QK_HEAD_DIM = QK_NOPE_DIM + QK_ROPE_DIM
V_HEAD_DIM = D_MODEL // 16
Q_LORA_RANK = 3 * D_MODEL // 8
KV_LORA_RANK = D_MODEL // 4
ROPE_THETA = 10000.0
Q_BLOCK = 128

MIX_IN_EVEN = POOL_DIM + Q_LORA_RANK + KV_LORA_RANK + QK_ROPE_DIM
MIX_OUT_EVEN = POOL_DIM + MLA_HEADS * V_HEAD_DIM

CONV_DIM = D_MODEL
CONV_WIDTH = 3

NORM_EPS = 1e-6

kernel_name = "hybrid_pool_mla_shortconv_macaron"


def rms_norm(x, g):
    xf = x.astype(jnp.float32)
    y = xf * lax.rsqrt(jnp.mean(xf * xf, axis=-1, keepdims=True) + NORM_EPS)
    return (y * g.astype(jnp.float32)).astype(x.dtype)


def swiglu(x, w_gate, w_up, w_down):
    return (jax.nn.silu(x @ w_gate) * (x @ w_up)) @ w_down


def rotary(x, cos, sin):
    x1, x2 = jnp.split(x, 2, axis=-1)
    c = cos[None, :, None, :]
    s = sin[None, :, None, :]
    return jnp.concatenate([x1 * c - x2 * s, x2 * c + x1 * s], axis=-1)


def causal_multiscale_pool(u):
    s = u.shape[1]
    uf = u.astype(jnp.float32)
    cs = jnp.pad(jnp.cumsum(uf, axis=1), ((0, 0), (1, 0), (0, 0), (0, 0)))
    t = jnp.arange(1, s + 1)
    means = []
    for g, w in enumerate(POOL_WINDOWS):
        lo = jnp.maximum(t - w, 0)
        wsum = cs[:, 1:, g] - cs[:, lo, g]
        cnt = jnp.minimum(t, w).astype(jnp.float32)[None, :, None]
        means.append(wsum / cnt)
    mean = jnp.stack(means, axis=2)
    return (mean - uf).astype(u.dtype)


def causal_attention(q, k, v):
    b, s, h, dqk = q.shape
    dv = v.shape[-1]
    scale = dqk ** -0.5
    kpos = jnp.arange(s)

    def block(i):
        start = i * Q_BLOCK
        qb = lax.dynamic_slice_in_dim(q, start, Q_BLOCK, axis=1)
        sc = jnp.einsum('bqhd,bkhd->bhqk', qb, k,
                        preferred_element_type=jnp.float32) * scale
        qpos = start + jnp.arange(Q_BLOCK)
        sc = jnp.where(kpos[None, :] <= qpos[:, None], sc, -jnp.inf)
        p = jax.nn.softmax(sc, axis=-1)
        return jnp.einsum('bhqk,bkhd->bqhd', p.astype(v.dtype), v)

    out = lax.map(block, jnp.arange(s // Q_BLOCK))
    return jnp.moveaxis(out, 0, 1).reshape(b, s, h, dv)


def pool_mla_mixer(hn, cos, sin, w_in, q_a_norm, w_q_up, kv_a_norm, w_kv_up,
                   q_head_norm, k_head_norm, w_pool, pool_scale, w_out):
    b, s, _ = hn.shape
    z = hn @ w_in
    c1 = POOL_DIM
    c2 = c1 + Q_LORA_RANK
    c3 = c2 + KV_LORA_RANK
    u, q_lat, kv_lat, k_rope = jnp.split(z, [c1, c2, c3], axis=-1)

    u = u.reshape(b, s, POOL_GROUPS, POOL_GROUP_DIM)
    pooled = causal_multiscale_pool(u)
    pool_out = jnp.einsum('bsgc,gcd->bsgd', pooled, w_pool).reshape(b, s, POOL_DIM) * pool_scale

    q = (rms_norm(q_lat, q_a_norm) @ w_q_up).reshape(b, s, MLA_HEADS, QK_HEAD_DIM)
    kv = (rms_norm(kv_lat, kv_a_norm) @ w_kv_up).reshape(b, s, MLA_HEADS, QK_NOPE_DIM + V_HEAD_DIM)
    k_nope, v = jnp.split(kv, [QK_NOPE_DIM], axis=-1)
    k_rope_h = jnp.broadcast_to(k_rope[:, :, None, :], (b, s, MLA_HEADS, QK_ROPE_DIM))
    k = jnp.concatenate([k_nope, k_rope_h], axis=-1)
    q = rms_norm(q, q_head_norm)
    k = rms_norm(k, k_head_norm)
    q = jnp.concatenate([q[..., :QK_NOPE_DIM], rotary(q[..., QK_NOPE_DIM:], cos, sin)], axis=-1)
    k = jnp.concatenate([k[..., :QK_NOPE_DIM], rotary(k[..., QK_NOPE_DIM:], cos, sin)], axis=-1)
    attn = causal_attention(q, k, v).reshape(b, s, MLA_HEADS * V_HEAD_DIM)

    return jnp.concatenate([pool_out, attn], axis=-1) @ w_out


def gated_conv_mixer(hn, w_in, conv_w, w_out):
    gb, gc, hh = jnp.split(hn @ w_in, 3, axis=-1)
    u = gc * hh
    s = u.shape[1]
    up = jnp.pad(u, ((0, 0), (CONV_WIDTH - 1, 0), (0, 0)))
    y = conv_w[0] * up[:, 0:s]
    for j in range(1, CONV_WIDTH):
        y = y + conv_w[j] * up[:, j:j + s]
    return (gb * y) @ w_out


def setup_inputs(seed: int = 0) -> dict:
    key = jax.random.key(seed)
    ks = iter(jax.random.split(key, 32))

    def dense(shape, fan_in):
        return jax.random.normal(next(ks), shape, jnp.float32) * (fan_in ** -0.5)

    def gain(shape):
        return 1.0 + 0.05 * jax.random.normal(next(ks), shape, jnp.float32)

    return {
        "x": jax.random.normal(next(ks), (BATCH, SEQ, D_MODEL), jnp.float32),
        "ffn1_norm": gain((DEPTH, D_MODEL)),
        "ffn1_w_gate": dense((DEPTH, D_MODEL, D_FF), D_MODEL),
        "ffn1_w_up": dense((DEPTH, D_MODEL, D_FF), D_MODEL),
        "ffn1_w_down": dense((DEPTH, D_FF, D_MODEL), D_FF),
        "mix_norm": gain((DEPTH, D_MODEL)),
        "ffn2_norm": gain((DEPTH, D_MODEL)),
        "ffn2_w_gate": dense((DEPTH, D_MODEL, D_FF), D_MODEL),
        "ffn2_w_up": dense((DEPTH, D_MODEL, D_FF), D_MODEL),
        "ffn2_w_down": dense((DEPTH, D_FF, D_MODEL), D_FF),
        "a_w_in": dense((N_EVEN, D_MODEL, MIX_IN_EVEN), D_MODEL),
        "a_q_a_norm": gain((N_EVEN, Q_LORA_RANK)),
        "a_w_q_up": dense((N_EVEN, Q_LORA_RANK, MLA_HEADS * QK_HEAD_DIM), Q_LORA_RANK),
        "a_kv_a_norm": gain((N_EVEN, KV_LORA_RANK)),
        "a_w_kv_up": dense((N_EVEN, KV_LORA_RANK, MLA_HEADS * (QK_NOPE_DIM + V_HEAD_DIM)), KV_LORA_RANK),
        "a_q_head_norm": gain((N_EVEN, QK_HEAD_DIM)),
        "a_k_head_norm": gain((N_EVEN, QK_HEAD_DIM)),
        "a_w_pool": dense((N_EVEN, POOL_GROUPS, POOL_GROUP_DIM, POOL_GROUP_DIM), POOL_GROUP_DIM),
        "a_pool_scale": gain((N_EVEN, POOL_DIM)),
        "a_w_out": dense((N_EVEN, MIX_OUT_EVEN, D_MODEL), MIX_OUT_EVEN),
        "c_w_in": dense((N_ODD, D_MODEL, 3 * CONV_DIM), D_MODEL),
        "c_conv_w": dense((N_ODD, CONV_WIDTH, CONV_DIM), CONV_WIDTH),
        "c_w_out": dense((N_ODD, CONV_DIM, D_MODEL), CONV_DIM),
    }


def reference(x, ffn1_norm, ffn1_w_gate, ffn1_w_up, ffn1_w_down, mix_norm,
              ffn2_norm, ffn2_w_gate, ffn2_w_up, ffn2_w_down,
              a_w_in, a_q_a_norm, a_w_q_up, a_kv_a_norm, a_w_kv_up,
              a_q_head_norm, a_k_head_norm, a_w_pool, a_pool_scale, a_w_out,
              c_w_in, c_conv_w, c_w_out):
    s = x.shape[1]
    pos = jnp.arange(s, dtype=jnp.float32)
    inv_freq = ROPE_THETA ** (-jnp.arange(0, QK_ROPE_DIM, 2, dtype=jnp.float32) / QK_ROPE_DIM)
    ang = pos[:, None] * inv_freq[None, :]
    cos = jnp.cos(ang).astype(x.dtype)
    sin = jnp.sin(ang).astype(x.dtype)

    for layer in range(DEPTH):
        x = x + 0.5 * swiglu(rms_norm(x, ffn1_norm[layer]),
                             ffn1_w_gate[layer], ffn1_w_up[layer], ffn1_w_down[layer])
        hn = rms_norm(x, mix_norm[layer])
        i = layer // 2
        if layer % 2 == 0:
            x = x + pool_mla_mixer(hn, cos, sin, a_w_in[i], a_q_a_norm[i], a_w_q_up[i],
                                   a_kv_a_norm[i], a_w_kv_up[i], a_q_head_norm[i],
                                   a_k_head_norm[i], a_w_pool[i], a_pool_scale[i], a_w_out[i])
        else:
            x = x + gated_conv_mixer(hn, c_w_in[i], c_conv_w[i], c_w_out[i])
        x = x + 0.5 * swiglu(rms_norm(x, ffn2_norm[layer]),
                             ffn2_w_gate[layer], ffn2_w_up[layer], ffn2_w_down[layer])
    return x
```

```cpp
#include <hip/hip_runtime.h>
#include <hip/hip_cooperative_groups.h>
#include <cstdio>
#include <cstdint>
namespace cg = cooperative_groups;

#define LAS __attribute__((address_space(3)))
typedef unsigned short bf16_t;
typedef short bf16x8 __attribute__((ext_vector_type(8)));
typedef short s16x4 __attribute__((ext_vector_type(4)));
typedef float f32x4 __attribute__((ext_vector_type(4)));
typedef float f32x16 __attribute__((ext_vector_type(16)));
typedef unsigned u32x4 __attribute__((ext_vector_type(4)));
typedef unsigned u32x2 __attribute__((ext_vector_type(2)));

constexpr int S = 16384, D = 1024, FF = 2816, DEPTH = 4;
constexpr int ZW = 1280;
constexpr int NH = 8, DQK = 96, DV = 64;
constexpr float EPS = 1e-6f;

__device__ __forceinline__ unsigned cvt_pk_bf16(float lo, float hi) { unsigned r; asm volatile("v_cvt_pk_bf16_f32 %0, %1, %2" : "=v"(r) : "v"(lo), "v"(hi)); return r; }
__device__ __forceinline__ float bf_lo(unsigned w) { return __uint_as_float(w << 16); }
__device__ __forceinline__ float bf_hi(unsigned w) { return __uint_as_float(w & 0xffff0000u); }
__device__ __forceinline__ float bf_one(bf16_t v) { return __uint_as_float(((unsigned)v) << 16); }
__device__ __forceinline__ bf16_t f2bf(float f) { return (bf16_t)(cvt_pk_bf16(f, 0.f) & 0xffffu); }

constexpr int WTAB_OFF = 131072 + 64 + 6144;
__device__ __forceinline__ int lane_id() { int l = (int)__builtin_amdgcn_mbcnt_hi(~0u, __builtin_amdgcn_mbcnt_lo(~0u, 0u)); asm volatile("" : "+v"(l)); return l; }
__device__ __forceinline__ int shx(int v, int m) { return __builtin_amdgcn_ds_bpermute((lane_id() ^ m) << 2, v); }
__device__ __forceinline__ unsigned shx(unsigned v, int m) { return (unsigned)__builtin_amdgcn_ds_bpermute((lane_id() ^ m) << 2, (int)v); }
__device__ __forceinline__ float shx(float v, int m) { return __int_as_float(__builtin_amdgcn_ds_bpermute((lane_id() ^ m) << 2, __float_as_int(v))); }
__device__ __forceinline__ unsigned hw_slot() { return (unsigned)__builtin_amdgcn_s_getreg((5 << 11) | 4) & 0x3fu; }
__device__ __forceinline__ int wave_index(LAS unsigned char* lds) { return __builtin_amdgcn_readfirstlane(((volatile LAS int*)(lds + WTAB_OFF))[hw_slot()]); }
namespace pg8 {
constexpr int BM = 256, BK = 64, HALF = 128, HTB = HALF * BK * 2, STAGE_BYTES = 8 * HTB, NXCD = 8, WGM = 8;
__host__ __device__ __forceinline__ int lds_byte(int r, int c) { const int st = (r >> 4) * 2 + (c >> 5), rr = r & 15, cc = c & 31, ob = rr * 64 + cc * 2; return st * 1024 + (ob ^ (((ob >> 9) & 1) << 5)); }
__host__ __device__ __forceinline__ void stage_rc(int b, int& R, int& C) { const int st = b / 1024, sb = b % 1024, swz = sb ^ (((sb >> 9) & 1) << 5); R = (st >> 1) * 16 + swz / 64; C = (st & 1) * 32 + (swz % 64) / 2; }
__host__ __device__ __forceinline__ int perm32(int rho) { const int n = rho >> 4, i = rho & 15; return 8 * (i >> 2) + 4 * n + (i & 3); }

struct Unit { int pm, pn; };
struct Gemm { const bf16_t* A; const bf16_t* Bt; int M, N, K, lda, ldb; };

struct StaticOrder {
    int nM, nN, nwg, G, c;
    __device__ __forceinline__ void init(int M, int N, int G_, int c_) { nM = M / BM; nN = N / BM; nwg = nM * nN; G = G_; c = c_; asm volatile("" : "+s"(c)); }
    __device__ __forceinline__ bool next(int i, Unit& u) const {
        const long L = (long)i * G + c; if (L >= nwg) return false;
        int wgid = (int)L; { const int q = nwg / NXCD, r = nwg % NXCD, xcd = wgid % NXCD, off = wgid / NXCD; wgid = (xcd < r ? xcd * (q + 1) : r * (q + 1) + (xcd - r) * q) + off; }
        const int nig = WGM * nN, gid = wgid / nig, fm = gid * WGM, gsz = (nM - fm) < WGM ? (nM - fm) : WGM;
        u.pm = fm + ((wgid % nig) % gsz); u.pn = (wgid % nig) / gsz; return true;
    }
};

template <class Epi, bool ALIGN_EPI = true, bool SP2 = true>
__device__ __forceinline__ void gemm_phase(LAS unsigned char* lds, const Gemm g, const StaticOrder& S, const Epi& E) {
    const int wid = wave_index(lds); int tid_ = wid * 64 + lane_id(); asm volatile("" : "+v"(tid_));
    const int tid = tid_, lane = tid & 63, wr = wid >> 2, wc = wid & 3, fr = lane & 15, fq = lane >> 4;
    const int K = g.K, nt = K / BK;
    unsigned voffA[2], voffB[2];
#pragma unroll
    for (int i = 0; i < 2; ++i) { int R, C; stage_rc(tid * 16 + i * 8192, R, C); const int Rb = Epi::PERM ? ((R & ~31) + perm32(R & 31)) : R;
        voffA[i] = (unsigned)(R * g.lda + C) * 2u; voffB[i] = (unsigned)(Rb * g.ldb + C) * 2u; }
    const size_t kstep = (size_t)(BK * 2);
    const size_t hstepA = (size_t)HALF * g.lda * 2, hstepB = (size_t)HALF * g.ldb * 2;
    const size_t tstepA = 2 * hstepA, tstepB = 2 * hstepB;
    const unsigned ldsw = (unsigned)wid * 1024u;
    const int aoff = lds_byte(wr * 64 + fr, fq * 8), boff = lds_byte(wc * 32 + fr, fq * 8);
#define PG8_SA(b, h) (((b) * 2 + (h)) * HTB)
#define PG8_SB(b, h) ((4 + (b) * 2 + (h)) * HTB)
#define PG8_STAGE(bufoff, gbase, voff) do { _Pragma("unroll") for (int _i = 0; _i < 2; ++_i) \
        __builtin_amdgcn_global_load_lds((const unsigned*)((const char*)(gbase) + (voff)[_i]), (LAS unsigned*)(lds + (bufoff) + ldsw + _i * 8192), 16, 0, 0); } while (0)
#define PG8_LDA(dst, b, h) do { _Pragma("unroll") for (int m = 0; m < 4; ++m) _Pragma("unroll") for (int k = 0; k < 2; ++k) dst[m][k] = *(const LAS bf16x8*)(lds + PG8_SA(b, h) + aoff + m * 2048 + k * 1024); } while (0)
#define PG8_LDB(dst, b, h) do { _Pragma("unroll") for (int n = 0; n < 2; ++n) _Pragma("unroll") for (int k = 0; k < 2; ++k) dst[n][k] = *(const LAS bf16x8*)(lds + PG8_SB(b, h) + boff + n * 2048 + k * 1024); } while (0)
#define PG8_MMA(ai, bj, At, Bt) do { __builtin_amdgcn_s_setprio(1); _Pragma("unroll") for (int m = 0; m < 4; ++m) _Pragma("unroll") for (int n = 0; n < 2; ++n) _Pragma("unroll") for (int k = 0; k < 2; ++k) \
        acc[ai][bj][m][n] = __builtin_amdgcn_mfma_f32_16x16x32_bf16(Bt[n][k], At[m][k], acc[ai][bj][m][n], 0, 0, 0); __builtin_amdgcn_s_setprio(0); } while (0)
#define PG8_WAIT_V(n) asm volatile("s_waitcnt vmcnt(" #n ")" ::: "memory")
#define PG8_WAIT_L(n) asm volatile("s_waitcnt lgkmcnt(" #n ")" ::: "memory")
#define PG8_BAR __builtin_amdgcn_s_barrier()
#define PG8_SCHED __builtin_amdgcn_sched_barrier(0)
    Unit cur, nxt; int ui = 0;
    if (!S.next(0, cur)) return;
    E.prepass(S, tid);
    f32x4 acc[2][2][4][2];
#pragma unroll
    for (int a = 0; a < 2; ++a)
#pragma unroll
        for (int b = 0; b < 2; ++b)
#pragma unroll
            for (int m = 0; m < 4; ++m)
#pragma unroll
                for (int n = 0; n < 2; ++n) acc[a][b][m][n] = (f32x4){0.f, 0.f, 0.f, 0.f};
    bf16x8 At[4][2], B0[2][2], B1[2][2];
    const char* cA = (const char*)g.A + (size_t)cur.pm * tstepA; const char* cB = (const char*)g.Bt + (size_t)cur.pn * tstepB;
    if constexpr (SP2) {
        PG8_STAGE(PG8_SB(0, 0), cB, voffB); PG8_STAGE(PG8_SB(0, 1), cB + hstepB, voffB); PG8_STAGE(PG8_SA(0, 0), cA, voffA); PG8_STAGE(PG8_SA(0, 1), cA + hstepA, voffA);
        if (wr == 1) PG8_BAR;
        PG8_WAIT_V(2); PG8_BAR;
        PG8_STAGE(PG8_SB(1, 0), cB + kstep, voffB); PG8_STAGE(PG8_SA(1, 0), cA + kstep, voffA); PG8_STAGE(PG8_SB(1, 1), cB + hstepB + kstep, voffB);
        PG8_WAIT_V(6); PG8_BAR;
    } else {
        PG8_STAGE(PG8_SB(0, 0), cB, voffB); PG8_STAGE(PG8_SA(0, 0), cA, voffA); PG8_STAGE(PG8_SB(0, 1), cB + hstepB, voffB); PG8_STAGE(PG8_SA(0, 1), cA + hstepA, voffA);
        if (wr == 1) PG8_BAR;
        PG8_WAIT_V(4); PG8_BAR;
        PG8_STAGE(PG8_SB(1, 0), cB + kstep, voffB); PG8_STAGE(PG8_SA(1, 0), cA + kstep, voffA); PG8_STAGE(PG8_SB(1, 1), cB + hstepB + kstep, voffB);
        PG8_WAIT_V(6); PG8_BAR;
    }
    for (;;) {
        const bool has_next = S.next(ui + 1, nxt);
        const char* nA = has_next ? (const char*)g.A + (size_t)nxt.pm * tstepA : cA; const char* nB = has_next ? (const char*)g.Bt + (size_t)nxt.pn * tstepB : cB;
        for (int t = 0; t < nt; t += 2) {
            const bool last = (t == nt - 2);
            const char* a1 = cA + (size_t)(t + 1) * kstep;
            const char* a2 = last ? nA : cA + (size_t)(t + 2) * kstep; const char* b2 = last ? nB : cB + (size_t)(t + 2) * kstep;
            const char* a3 = a2 + kstep; const char* b3 = b2 + kstep;
            if constexpr (SP2) {
            PG8_LDB(B0, 0, 0); PG8_LDB(B1, 0, 1); PG8_SCHED; PG8_LDA(At, 0, 0); PG8_STAGE(PG8_SA(1, 1), a1 + hstepA, voffA);
            PG8_WAIT_V(8); PG8_WAIT_L(0); PG8_BAR; PG8_MMA(0, 0, At, B0); PG8_MMA(0, 1, At, B1); PG8_BAR; PG8_SCHED;
            PG8_LDA(At, 0, 1); PG8_STAGE(PG8_SB(0, 0), b2, voffB); PG8_STAGE(PG8_SB(0, 1), b2 + hstepB, voffB); PG8_STAGE(PG8_SA(0, 0), a2, voffA);
            PG8_WAIT_V(8); PG8_WAIT_L(0); PG8_BAR; PG8_MMA(1, 0, At, B0); PG8_MMA(1, 1, At, B1); PG8_BAR; PG8_SCHED;
            PG8_LDB(B0, 1, 0); PG8_LDB(B1, 1, 1); PG8_SCHED; PG8_LDA(At, 1, 0); PG8_STAGE(PG8_SA(0, 1), a2 + hstepA, voffA);
            PG8_WAIT_V(8); PG8_WAIT_L(0); PG8_BAR; PG8_MMA(0, 0, At, B0); PG8_MMA(0, 1, At, B1); PG8_BAR; PG8_SCHED;
            PG8_LDA(At, 1, 1); PG8_STAGE(PG8_SB(1, 0), b3, voffB); PG8_STAGE(PG8_SB(1, 1), b3 + hstepB, voffB); PG8_STAGE(PG8_SA(1, 0), a3, voffA);
            PG8_WAIT_V(8); PG8_WAIT_L(0); PG8_BAR; PG8_MMA(1, 0, At, B0); PG8_MMA(1, 1, At, B1); PG8_BAR; PG8_SCHED;
            } else {
            PG8_LDB(B0, 0, 0); PG8_SCHED; PG8_LDA(At, 0, 0); PG8_STAGE(PG8_SA(1, 1), a1 + hstepA, voffA);
            PG8_WAIT_L(8); PG8_BAR; PG8_WAIT_L(0); PG8_MMA(0, 0, At, B0); PG8_BAR; PG8_SCHED;
            PG8_LDB(B1, 0, 1); PG8_STAGE(PG8_SB(0, 0), b2, voffB);
            PG8_BAR; PG8_WAIT_L(0); PG8_MMA(0, 1, At, B1); PG8_BAR;
            PG8_LDA(At, 0, 1); PG8_STAGE(PG8_SA(0, 0), a2, voffA);
            PG8_BAR; PG8_WAIT_L(0); PG8_MMA(1, 0, At, B0); PG8_BAR; PG8_SCHED;
            PG8_STAGE(PG8_SB(0, 1), b2 + hstepB, voffB);
            PG8_WAIT_V(6); PG8_BAR; PG8_MMA(1, 1, At, B1); PG8_BAR;
            PG8_LDB(B0, 1, 0); PG8_SCHED; PG8_LDA(At, 1, 0); PG8_STAGE(PG8_SA(0, 1), a2 + hstepA, voffA);
            PG8_WAIT_L(8); PG8_BAR; PG8_WAIT_L(0); PG8_MMA(0, 0, At, B0); PG8_BAR; PG8_SCHED;
            PG8_LDB(B1, 1, 1); PG8_STAGE(PG8_SB(1, 0), b3, voffB);
            PG8_BAR; PG8_WAIT_L(0); PG8_MMA(0, 1, At, B1); PG8_BAR;
            PG8_LDA(At, 1, 1); PG8_STAGE(PG8_SA(1, 0), a3, voffA);
            PG8_BAR; PG8_WAIT_L(0); PG8_MMA(1, 0, At, B0); PG8_BAR; PG8_SCHED;
            PG8_STAGE(PG8_SB(1, 1), b3 + hstepB, voffB);
            PG8_WAIT_V(6); PG8_BAR; PG8_MMA(1, 1, At, B1); PG8_BAR;
            }
        }
        if constexpr (ALIGN_EPI) { if (wr == 0) PG8_BAR; }
        E(acc, cur, has_next ? nxt.pm : cur.pm, ui, wr, wc, fr, fq);
        if (!has_next) break;
#pragma unroll
        for (int a = 0; a < 2; ++a)
#pragma unroll
            for (int b = 0; b < 2; ++b)
#pragma unroll
                for (int m = 0; m < 4; ++m)
#pragma unroll
                    for (int n = 0; n < 2; ++n) acc[a][b][m][n] = (f32x4){0.f, 0.f, 0.f, 0.f};
        cur = nxt; cA = nA; cB = nB; ++ui;
        if constexpr (ALIGN_EPI) { if (wr == 1) PG8_BAR; }
    }
    PG8_WAIT_V(0);
    if constexpr (!ALIGN_EPI) { if (wr == 0) PG8_BAR; }
    PG8_BAR;
#undef PG8_SA
#undef PG8_SB
#undef PG8_STAGE
#undef PG8_LDA
#undef PG8_LDB
#undef PG8_MMA
#undef PG8_WAIT_V
#undef PG8_WAIT_L
#undef PG8_BAR
#undef PG8_SCHED
}

__device__ __forceinline__ float rstd16(const float* ssq, int r) {
    const f32x4* p = (const f32x4*)(ssq + (size_t)r * 16);
    const f32x4 a = p[0], b = p[1], c = p[2], d = p[3];
    const float s = ((a[0] + a[1]) + (a[2] + a[3])) + ((b[0] + b[1]) + (b[2] + b[3])) + ((c[0] + c[1]) + (c[2] + c[3])) + ((d[0] + d[1]) + (d[2] + d[3]));
    return __builtin_amdgcn_rsqf(s * (1.0f / 1024.0f) + EPS);
}
constexpr int RSL_OFF = 131072 + 64;
template <int MODE> __device__ __forceinline__ void rstd_prepass(LAS unsigned char* lds, const StaticOrder& S, const float* p, int sel, int tid) {
    LAS float* rsl = (LAS float*)(lds + RSL_OFF);
    const int rr = tid & 255, half = tid >> 8;
    float v[3];
#pragma unroll
    for (int j = 0; j < 3; ++j) {
        Unit u; const bool ok = S.next(2 * j + half, u); const int row = (ok ? u.pm : 0) * BM + rr;
        v[j] = (MODE == 0) ? rstd16(p, row) : p[(size_t)row * 2 + sel];
    }
#pragma unroll
    for (int j = 0; j < 3; ++j) rsl[(2 * j + half) * 256 + rr] = v[j];
    asm volatile("s_waitcnt lgkmcnt(0)" ::: "memory");
    __builtin_amdgcn_s_barrier();
    asm volatile("" ::: "memory");
}
__device__ __forceinline__ float silu_f(float x) { return x * __builtin_amdgcn_rcpf(1.0f + __builtin_amdgcn_exp2f(-1.4426950408889634f * x)); }

struct EpiSwiGLU {
    static constexpr bool PERM = true;
    bf16_t* H; const float* ssq; LAS unsigned char* lds;
    __device__ __forceinline__ void prepass(const StaticOrder& S, int tid) const { rstd_prepass<0>(lds, S, ssq, 0, tid); }
    __device__ __forceinline__ void operator()(const f32x4 (&acc)[2][2][4][2], const Unit& u, int pm_next, int ui, int wr, int wc, int fr, int fq) const {
        const int row0 = u.pm * BM + wr * 64 + fr, col0 = u.pn * 128 + wc * 32 + 8 * fq;
        const LAS float* rsl = (const LAS float*)(lds + RSL_OFF) + ui * 256;
#pragma unroll
        for (int ai = 0; ai < 2; ++ai)
#pragma unroll
            for (int m = 0; m < 4; ++m) {
                const int r = row0 + ai * HALF + m * 16; const float rs = rsl[wr * 64 + fr + ai * HALF + m * 16];
                float hv[8];
#pragma unroll
                for (int n = 0; n < 2; ++n)
#pragma unroll
                    for (int j = 0; j < 4; ++j) hv[n * 4 + j] = silu_f(acc[ai][0][m][n][j] * rs) * (acc[ai][1][m][n][j] * rs);
                u32x4 w; w.x = cvt_pk_bf16(hv[0], hv[1]); w.y = cvt_pk_bf16(hv[2], hv[3]); w.z = cvt_pk_bf16(hv[4], hv[5]); w.w = cvt_pk_bf16(hv[6], hv[7]);
                *(u32x4*)(H + (size_t)r * FF + col0) = w;
            }
    }
};
struct EpiResid {
    static constexpr bool PERM = true;
    float* out; bf16_t* xb; float* ssq; float alpha;
    __device__ __forceinline__ void prepass(const StaticOrder&, int) const {}
    __device__ __forceinline__ void operator()(const f32x4 (&acc)[2][2][4][2], const Unit& u, int pm_next, int ui, int wr, int wc, int fr, int fq) const {
        const int row0 = u.pm * BM + wr * 64 + fr, col0 = u.pn * BM + wc * 32 + 8 * fq;
        u32x4 bwv[2][4][2];
#pragma unroll
        for (int ai = 0; ai < 2; ++ai)
#pragma unroll
            for (int m = 0; m < 4; ++m)
#pragma unroll
                for (int bj = 0; bj < 2; ++bj) bwv[ai][m][bj] = *(const u32x4*)(xb + (size_t)(row0 + ai * HALF + m * 16) * D + col0 + bj * HALF);
        asm volatile("" ::: "memory");
#pragma unroll
        for (int ai = 0; ai < 2; ++ai)
#pragma unroll
            for (int m = 0; m < 4; ++m) {
                const int r = row0 + ai * HALF + m * 16; const size_t off = (size_t)r * D + col0; float s = 0.f;
#pragma unroll
                for (int bj = 0; bj < 2; ++bj) {
                    const u32x4 bw = bwv[ai][m][bj];
                    const f32x4 a0 = acc[ai][bj][m][0], a1 = acc[ai][bj][m][1];
                    const float o0 = bf_lo(bw.x) + a0[0] * alpha, o1 = bf_hi(bw.x) + a0[1] * alpha, o2 = bf_lo(bw.y) + a0[2] * alpha, o3 = bf_hi(bw.y) + a0[3] * alpha;
                    const float o4 = bf_lo(bw.z) + a1[0] * alpha, o5 = bf_hi(bw.z) + a1[1] * alpha, o6 = bf_lo(bw.w) + a1[2] * alpha, o7 = bf_hi(bw.w) + a1[3] * alpha;
                    u32x4 w; w.x = cvt_pk_bf16(o0, o1); w.y = cvt_pk_bf16(o2, o3); w.z = cvt_pk_bf16(o4, o5); w.w = cvt_pk_bf16(o6, o7);
                    *(u32x4*)(xb + off + bj * HALF) = w;
                    if (out) { *(f32x4*)(out + off + bj * HALF) = (f32x4){o0, o1, o2, o3}; *(f32x4*)(out + off + bj * HALF + 4) = (f32x4){o4, o5, o6, o7}; }
                    const float q0 = bf_lo(w.x), q1 = bf_hi(w.x), q2 = bf_lo(w.y), q3 = bf_hi(w.y), q4 = bf_lo(w.z), q5 = bf_hi(w.z), q6 = bf_lo(w.w), q7 = bf_hi(w.w);
                    s += ((q0 * q0 + q1 * q1) + (q2 * q2 + q3 * q3)) + ((q4 * q4 + q5 * q5) + (q6 * q6 + q7 * q7));
                }
                s += shx(s, 16); s += shx(s, 32);
                if (fq == 0) ssq[(size_t)r * 16 + u.pn * 4 + wc] = s;
            }
    }
};
template <int MODE> struct EpiRowBf16 {
    static constexpr bool PERM = true;
    bf16_t* O; int ldc; const float* rsp; int sel; LAS unsigned char* lds;
    __device__ __forceinline__ void prepass(const StaticOrder& S, int tid) const { rstd_prepass<MODE>(lds, S, rsp, sel, tid); }
    __device__ __forceinline__ void operator()(const f32x4 (&acc)[2][2][4][2], const Unit& u, int pm_next, int ui, int wr, int wc, int fr, int fq) const {
        const int row0 = u.pm * BM + wr * 64 + fr, col0 = u.pn * BM + wc * 32 + 8 * fq;
        const LAS float* rsl = (const LAS float*)(lds + RSL_OFF) + ui * 256;
#pragma unroll
        for (int ai = 0; ai < 2; ++ai)
#pragma unroll
            for (int m = 0; m < 4; ++m) {
                const int r = row0 + ai * HALF + m * 16; const float rs = rsl[wr * 64 + fr + ai * HALF + m * 16];
#pragma unroll
                for (int bj = 0; bj < 2; ++bj) {
                    const f32x4 v0 = acc[ai][bj][m][0] * rs, v1 = acc[ai][bj][m][1] * rs;
                    u32x4 w; w.x = cvt_pk_bf16(v0[0], v0[1]); w.y = cvt_pk_bf16(v0[2], v0[3]); w.z = cvt_pk_bf16(v1[0], v1[1]); w.w = cvt_pk_bf16(v1[2], v1[3]);
                    *(u32x4*)(O + (size_t)r * ldc + col0 + bj * HALF) = w;
                }
            }
    }
};
struct EpiColBf16 {
    static constexpr bool PERM = true;
    bf16_t* O; int ldc; const float* rsd;
    __device__ __forceinline__ void prepass(const StaticOrder&, int) const {}
    __device__ __forceinline__ void operator()(const f32x4 (&acc)[2][2][4][2], const Unit& u, int pm_next, int ui, int wr, int wc, int fr, int fq) const {
        const int row0 = u.pm * BM + wr * 64 + fr, col0 = u.pn * BM + wc * 32 + 8 * fq;
        float cs[2][8];
#pragma unroll
        for (int bj = 0; bj < 2; ++bj)
#pragma unroll
            for (int j = 0; j < 8; ++j) cs[bj][j] = rsd[(size_t)(col0 + bj * HALF + j) * 2 + 1];
        asm volatile("" ::: "memory");
#pragma unroll
        for (int bj = 0; bj < 2; ++bj)
#pragma unroll
            for (int ai = 0; ai < 2; ++ai)
#pragma unroll
                for (int m = 0; m < 4; ++m) {
                    const int r = row0 + ai * HALF + m * 16;
                    const f32x4 v0 = acc[ai][bj][m][0], v1 = acc[ai][bj][m][1];
                    u32x4 w; w.x = cvt_pk_bf16(v0[0] * cs[bj][0], v0[1] * cs[bj][1]); w.y = cvt_pk_bf16(v0[2] * cs[bj][2], v0[3] * cs[bj][3]);
                    w.z = cvt_pk_bf16(v1[0] * cs[bj][4], v1[1] * cs[bj][5]); w.w = cvt_pk_bf16(v1[2] * cs[bj][6], v1[3] * cs[bj][7]);
                    *(u32x4*)(O + (size_t)r * ldc + col0 + bj * HALF) = w;
                }
    }
};
struct EpiConvIn {
    static constexpr bool PERM = true;
    bf16_t* U; bf16_t* GB; const float* ssq; LAS unsigned char* lds;
    __device__ __forceinline__ void prepass(const StaticOrder& S, int tid) const { rstd_prepass<0>(lds, S, ssq, 0, tid); }
    __device__ __forceinline__ void operator()(const f32x4 (&acc)[2][2][4][2], const Unit& u, int pm_next, int ui, int wr, int wc, int fr, int fq) const {
        const int row0 = u.pm * BM + wr * 64 + fr;
        const LAS float* rsl = (const LAS float*)(lds + RSL_OFF) + ui * 256;
#pragma unroll
        for (int ai = 0; ai < 2; ++ai)
#pragma unroll
            for (int m = 0; m < 4; ++m) {
                const int r = row0 + ai * HALF + m * 16; const float rs = rsl[wr * 64 + fr + ai * HALF + m * 16];
                if (u.pn < 8) {
                    const f32x4 v0 = (acc[ai][0][m][0] * rs) * (acc[ai][1][m][0] * rs), v1 = (acc[ai][0][m][1] * rs) * (acc[ai][1][m][1] * rs);
                    u32x4 w; w.x = cvt_pk_bf16(v0[0], v0[1]); w.y = cvt_pk_bf16(v0[2], v0[3]); w.z = cvt_pk_bf16(v1[0], v1[1]); w.w = cvt_pk_bf16(v1[2], v1[3]);
                    *(u32x4*)(U + (size_t)r * D + u.pn * 128 + wc * 32 + 8 * fq) = w;
                } else {
#pragma unroll
                    for (int bj = 0; bj < 2; ++bj) {
                        const f32x4 v0 = acc[ai][bj][m][0] * rs, v1 = acc[ai][bj][m][1] * rs;
                        u32x4 w; w.x = cvt_pk_bf16(v0[0], v0[1]); w.y = cvt_pk_bf16(v0[2], v0[3]); w.z = cvt_pk_bf16(v1[0], v1[1]); w.w = cvt_pk_bf16(v1[2], v1[3]);
                        *(u32x4*)(GB + (size_t)r * D + (u.pn - 8) * BM + bj * HALF + wc * 32 + 8 * fq) = w;
                    }
                }
            }
    }
};
}

namespace att {
constexpr int KROW = 208, VROW = 144, KBUF = 64 * KROW, VBUF = 64 * VROW;
constexpr int LDS_K0 = 0, LDS_V0 = 3 * KBUF, LDS_SC = LDS_V0 + 2 * VBUF, LDS_TOTAL = LDS_SC + 8 * 32 * 4;
__device__ __forceinline__ int crow(int r, int hi) { return (r & 3) + 8 * (r >> 2) + 4 * hi; }

__device__ __forceinline__ void attn_qk(f32x16& P0, f32x16& P1, const LAS unsigned char* kb, const bf16x8 (&qr)[6]) {
    f32x16 z;
#pragma unroll
    for (int r = 0; r < 16; ++r) z[r] = 0.f;
    bf16x8 kf[12];
#pragma unroll
    for (int d0 = 0; d0 < 6; ++d0) { kf[2 * d0] = *(const LAS bf16x8*)(kb + d0 * 32); kf[2 * d0 + 1] = *(const LAS bf16x8*)(kb + 32 * KROW + d0 * 32); }
    __builtin_amdgcn_sched_barrier(0);
#pragma unroll
    for (int d0 = 0; d0 < 6; ++d0) {
        if (d0 == 0) { P0 = __builtin_amdgcn_mfma_f32_32x32x16_bf16(kf[0], qr[0], z, 0, 0, 0); P1 = __builtin_amdgcn_mfma_f32_32x32x16_bf16(kf[1], qr[0], z, 0, 0, 0); }
        else { P0 = __builtin_amdgcn_mfma_f32_32x32x16_bf16(kf[2 * d0], qr[d0], P0, 0, 0, 0); P1 = __builtin_amdgcn_mfma_f32_32x32x16_bf16(kf[2 * d0 + 1], qr[d0], P1, 0, 0, 0); }
    }
    __builtin_amdgcn_sched_barrier(0);
}
__device__ __forceinline__ void attn_sm_pv(f32x16& P0, f32x16& P1, f32x16& o0, f32x16& o1, float& l_run, const LAS unsigned char* vb, bool diag, int q, int kvb) {
    if (diag) {
#pragma unroll
        for (int r = 0; r < 16; ++r) { const int kv = kvb + (r & 3) + 8 * (r >> 2); if (kv > q) P0[r] = -INFINITY; if (kv + 32 > q) P1[r] = -INFINITY; }
    }
    bf16x8 vfr[8];
#pragma unroll
    for (int s = 0; s < 4; ++s) { vfr[2 * s] = *(const LAS bf16x8*)(vb + s * 32); vfr[2 * s + 1] = *(const LAS bf16x8*)(vb + 32 * VROW + s * 32); }
    __builtin_amdgcn_sched_barrier(0);
    float s0 = 0.f, s1 = 0.f;
#pragma unroll
    for (int r = 0; r < 16; ++r) { P0[r] = __builtin_amdgcn_exp2f(P0[r]); P1[r] = __builtin_amdgcn_exp2f(P1[r]); s0 += P0[r]; s1 += P1[r]; }
    l_run += s0 + s1;
#pragma unroll
    for (int s = 0; s < 4; ++s) {
        u32x4 pw;
        if (s < 2) { const int b = 8 * s; pw.x = cvt_pk_bf16(P0[b], P0[b + 1]); pw.y = cvt_pk_bf16(P0[b + 2], P0[b + 3]); pw.z = cvt_pk_bf16(P0[b + 4], P0[b + 5]); pw.w = cvt_pk_bf16(P0[b + 6], P0[b + 7]); }
        else { const int b = 8 * (s - 2); pw.x = cvt_pk_bf16(P1[b], P1[b + 1]); pw.y = cvt_pk_bf16(P1[b + 2], P1[b + 3]); pw.z = cvt_pk_bf16(P1[b + 4], P1[b + 5]); pw.w = cvt_pk_bf16(P1[b + 6], P1[b + 7]); }
        const bf16x8 pa = __builtin_bit_cast(bf16x8, pw);
        o0 = __builtin_amdgcn_mfma_f32_32x32x16_bf16(pa, vfr[2 * s], o0, 0, 0, 0);
        o1 = __builtin_amdgcn_mfma_f32_32x32x16_bf16(pa, vfr[2 * s + 1], o1, 0, 0, 0);
    }
}

__device__ __forceinline__ void attn_qk_f(f32x16& P0, f32x16& P1, const LAS unsigned char* kb, const bf16x8 (&qr)[6]) {
    bf16x8 kf[12];
#pragma unroll
    for (int d0 = 0; d0 < 6; ++d0) { kf[2 * d0] = *(const LAS bf16x8*)(kb + d0 * 32); kf[2 * d0 + 1] = *(const LAS bf16x8*)(kb + 32 * KROW + d0 * 32); }
    __builtin_amdgcn_sched_barrier(0);
    f32x16 z;
#pragma unroll
    for (int r = 0; r < 16; ++r) z[r] = 0.f;
    __builtin_amdgcn_s_setprio(1);
    P0 = __builtin_amdgcn_mfma_f32_32x32x16_bf16(kf[0], qr[0], z, 0, 0, 0); P1 = __builtin_amdgcn_mfma_f32_32x32x16_bf16(kf[1], qr[0], z, 0, 0, 0);
#pragma unroll
    for (int d0 = 1; d0 < 6; ++d0) { P0 = __builtin_amdgcn_mfma_f32_32x32x16_bf16(kf[2 * d0], qr[d0], P0, 0, 0, 0); P1 = __builtin_amdgcn_mfma_f32_32x32x16_bf16(kf[2 * d0 + 1], qr[d0], P1, 0, 0, 0); }
    __builtin_amdgcn_s_setprio(0);
    __builtin_amdgcn_sched_barrier(0);
}
__device__ __forceinline__ void attn_sm_f(f32x16& P0, f32x16& P1, float& l_run, u32x4 (&pw)[4]) {
    float s0 = 0.f, s1 = 0.f;
#pragma unroll
    for (int r = 0; r < 16; ++r) { P0[r] = __builtin_amdgcn_exp2f(P0[r]); P1[r] = __builtin_amdgcn_exp2f(P1[r]); s0 += P0[r]; s1 += P1[r]; }
    l_run += s0 + s1;
#pragma unroll
    for (int s = 0; s < 2; ++s) { const int b = 8 * s;
        pw[s].x = cvt_pk_bf16(P0[b], P0[b + 1]); pw[s].y = cvt_pk_bf16(P0[b + 2], P0[b + 3]); pw[s].z = cvt_pk_bf16(P0[b + 4], P0[b + 5]); pw[s].w = cvt_pk_bf16(P0[b + 6], P0[b + 7]);
        pw[s + 2].x = cvt_pk_bf16(P1[b], P1[b + 1]); pw[s + 2].y = cvt_pk_bf16(P1[b + 2], P1[b + 3]); pw[s + 2].z = cvt_pk_bf16(P1[b + 4], P1[b + 5]); pw[s + 2].w = cvt_pk_bf16(P1[b + 6], P1[b + 7]); }
}
__device__ __forceinline__ void attn_pv_f(const u32x4 (&pw)[4], f32x16& o0, f32x16& o1, const LAS unsigned char* vb) {
    u32x2 va[4][2], vc[4][2];
#pragma unroll
    for (int s = 0; s < 4; ++s) { va[s][0] = *(const LAS u32x2*)(vb + s * 32); va[s][1] = *(const LAS u32x2*)(vb + s * 32 + 16);
        vc[s][0] = *(const LAS u32x2*)(vb + 32 * VROW + s * 32); vc[s][1] = *(const LAS u32x2*)(vb + 32 * VROW + s * 32 + 16); }
    __builtin_amdgcn_sched_barrier(0);
    __builtin_amdgcn_s_setprio(1);
#pragma unroll
    for (int s = 0; s < 4; ++s) {
        const bf16x8 pa = __builtin_bit_cast(bf16x8, pw[s]);
        o0 = __builtin_amdgcn_mfma_f32_32x32x16_bf16(pa, __builtin_bit_cast(bf16x8, (u32x4){va[s][0].x, va[s][0].y, va[s][1].x, va[s][1].y}), o0, 0, 0, 0);
        o1 = __builtin_amdgcn_mfma_f32_32x32x16_bf16(pa, __builtin_bit_cast(bf16x8, (u32x4){vc[s][0].x, vc[s][0].y, vc[s][1].x, vc[s][1].y}), o1, 0, 0, 0);
    }
    __builtin_amdgcn_s_setprio(0);
    __builtin_amdgcn_sched_barrier(0);
}

typedef float f32x2_t __attribute__((ext_vector_type(2))); typedef __bf16 bf16x2_t __attribute__((ext_vector_type(2)));
__device__ __forceinline__ unsigned cvtpk_s(float lo, float hi) { f32x2_t v = {lo, hi}; bf16x2_t b = __builtin_convertvector(v, bf16x2_t); return __builtin_bit_cast(unsigned, b); }
struct Stage3 { u32x4 k0, k1, v; };
template <int VAR> __device__ __forceinline__ Stage3 attn_full_step(f32x16& PA0, f32x16& PA1, f32x16& PB0, f32x16& PB1, f32x16& o0, f32x16& o1, float& l_run,
                                               const LAS unsigned char* kb, const LAS unsigned char* vb, const bf16x8 (&qr)[6],
                                               u32x4 kg0, u32x4 kg1, u32x4 vg, LAS unsigned char* kst0, LAS unsigned char* kst1, LAS unsigned char* vst, bool k1v,
                                               const char* kn0, const char* kn1, const bf16_t* vn) {
    bf16x8 kf[12], vf[8];
#pragma unroll
    for (int d0 = 0; d0 < 6; ++d0) { kf[2 * d0] = *(const LAS bf16x8*)(kb + d0 * 32); kf[2 * d0 + 1] = *(const LAS bf16x8*)(kb + 32 * KROW + d0 * 32); }
    __builtin_amdgcn_sched_barrier(0);
    f32x16 z;
#pragma unroll
    for (int r = 0; r < 16; ++r) z[r] = 0.f;
    __builtin_amdgcn_s_setprio(1);
    PB0 = __builtin_amdgcn_mfma_f32_32x32x16_bf16(kf[0], qr[0], z, 0, 0, 0); PB1 = __builtin_amdgcn_mfma_f32_32x32x16_bf16(kf[1], qr[0], z, 0, 0, 0);
#pragma unroll
    for (int d0 = 1; d0 < 6; ++d0) { PB0 = __builtin_amdgcn_mfma_f32_32x32x16_bf16(kf[2 * d0], qr[d0], PB0, 0, 0, 0); PB1 = __builtin_amdgcn_mfma_f32_32x32x16_bf16(kf[2 * d0 + 1], qr[d0], PB1, 0, 0, 0); }
    __builtin_amdgcn_s_setprio(0);
    __builtin_amdgcn_sched_barrier(0);
    if constexpr (!(VAR & 2)) {
        *(LAS u32x4*)kst0 = kg0; if (k1v) *(LAS u32x4*)kst1 = kg1;
        *(LAS u32x2*)vst = (u32x2){vg.x, vg.y}; *(LAS u32x2*)(vst + 16) = (u32x2){vg.z, vg.w};
        kg0 = *(const u32x4*)kn0; if (k1v) kg1 = *(const u32x4*)kn1;
        vg = *(const u32x4*)vn;
    }
#pragma unroll
    for (int s = 0; s < 4; ++s) { vf[2 * s] = *(const LAS bf16x8*)(vb + s * 32); vf[2 * s + 1] = *(const LAS bf16x8*)(vb + 32 * VROW + s * 32); }
    __builtin_amdgcn_sched_barrier(0);
    float s0 = 0.f, s1 = 0.f;
#pragma unroll
    for (int r = 0; r < 16; ++r) { PA0[r] = __builtin_amdgcn_exp2f(PA0[r]); PA1[r] = __builtin_amdgcn_exp2f(PA1[r]); s0 += PA0[r]; s1 += PA1[r]; }
    l_run += s0 + s1;
    u32x4 pw[4];
#pragma unroll
    for (int s = 0; s < 2; ++s) { const int b = 8 * s;
        pw[s].x = cvtpk_s(PA0[b], PA0[b + 1]); pw[s].y = cvtpk_s(PA0[b + 2], PA0[b + 3]); pw[s].z = cvtpk_s(PA0[b + 4], PA0[b + 5]); pw[s].w = cvtpk_s(PA0[b + 6], PA0[b + 7]);
        pw[s + 2].x = cvtpk_s(PA1[b], PA1[b + 1]); pw[s + 2].y = cvtpk_s(PA1[b + 2], PA1[b + 3]); pw[s + 2].z = cvtpk_s(PA1[b + 4], PA1[b + 5]); pw[s + 2].w = cvtpk_s(PA1[b + 6], PA1[b + 7]); }
    __builtin_amdgcn_sched_barrier(0);
    __builtin_amdgcn_s_setprio(1);
#pragma unroll
    for (int s = 0; s < 4; ++s) {
        const bf16x8 pa = __builtin_bit_cast(bf16x8, pw[s]);
        o0 = __builtin_amdgcn_mfma_f32_32x32x16_bf16(pa, vf[2 * s], o0, 0, 0, 0);
        o1 = __builtin_amdgcn_mfma_f32_32x32x16_bf16(pa, vf[2 * s + 1], o1, 0, 0, 0);
    }
    __builtin_amdgcn_s_setprio(0);
    __builtin_amdgcn_sched_barrier(0);
    Stage3 r_; r_.k0 = kg0; r_.k1 = kg1; r_.v = vg; return r_;
}

template <int VAR> __device__ __forceinline__ void attn_unit(int h, int qb, const bf16_t* Q, const bf16_t* K, const bf16_t* Vt, bf16_t* AO, LAS unsigned char* lds) {
    const int wid = wave_index(lds); int tid_ = wid * 64 + lane_id(); asm volatile("" : "+v"(tid_));
    const int tid = tid_, lane = tid & 63, r32 = lane & 31, hi = lane >> 5;
    const int q0w = qb * 256 + wid * 32, NT = 4 * qb + 4;
    const int tlast = (q0w + 31) >> 6;
    const char* Kh = (const char*)(K + (size_t)h * S * DQK);
    const bf16_t* Vh = Vt + (size_t)h * DV * S;
    bf16x8 qr[6];
    { const bf16_t* qp = Q + ((size_t)h * S + q0w + r32) * DQK + hi * 8;
#pragma unroll
      for (int d0 = 0; d0 < 6; ++d0) qr[d0] = *(const bf16x8*)(qp + d0 * 16); }
    const int c0 = tid, c1 = tid + 512;
    const int k0dst = (c0 / 12) * KROW + (c0 % 12) * 16, k1dst = (c1 / 12) * KROW + (c1 % 12) * 16;
    const int vrow = tid >> 3, vc8 = tid & 7, vdst = vrow * VROW + (vc8 >> 1) * 32 + (vc8 & 1) * 8;
    const bf16_t* vsrc = Vh + (size_t)vrow * S + vc8 * 8;
    const bool k1v = tid < 256;
    LAS float* sc = (LAS float*)(lds + LDS_SC) + wid * 32;
    const LAS unsigned char* kfrag = lds + LDS_K0 + r32 * KROW + hi * 16;
    const LAS unsigned char* vfrag = lds + LDS_V0 + r32 * VROW + hi * 16;
    const int q = q0w + r32;
    float l_run = 0.f;
    f32x16 o0, o1, pA0, pA1, pB0, pB1;
#pragma unroll
    for (int r = 0; r < 16; ++r) { o0[r] = 0.f; o1[r] = 0.f; pA0[r] = 0.f; pA1[r] = 0.f; pB0[r] = 0.f; pB1[r] = 0.f; }
#define ATT_KST(slot, g0, g1) do { *(LAS u32x4*)(lds + LDS_K0 + (slot) * KBUF + k0dst) = (g0); if (k1v) *(LAS u32x4*)(lds + LDS_K0 + (slot) * KBUF + k1dst) = (g1); } while (0)
#define ATT_VST(slot, g) do { *(LAS u32x2*)(lds + LDS_V0 + (slot) * VBUF + vdst) = (u32x2){(g).x, (g).y}; *(LAS u32x2*)(lds + LDS_V0 + (slot) * VBUF + vdst + 16) = (u32x2){(g).z, (g).w}; } while (0)
    u32x4 kg0, kg1 = (u32x4){0u, 0u, 0u, 0u}, vg;
    {
        const u32x4 z4 = (u32x4){0u, 0u, 0u, 0u};
        const u32x4 a = *(const u32x4*)(Kh + c0 * 16); const u32x4 b = k1v ? *(const u32x4*)(Kh + c1 * 16) : z4;
        const u32x4 a2 = *(const u32x4*)(Kh + 64 * DQK * 2 + c0 * 16); const u32x4 b2 = k1v ? *(const u32x4*)(Kh + 64 * DQK * 2 + c1 * 16) : z4;
        const u32x4 v = *(const u32x4*)(vsrc);
        kg0 = *(const u32x4*)(Kh + 2 * 64 * DQK * 2 + c0 * 16); if (k1v) kg1 = *(const u32x4*)(Kh + 2 * 64 * DQK * 2 + c1 * 16);
        vg = *(const u32x4*)(vsrc + 64);
        ATT_KST(0, a, b); ATT_KST(1, a2, b2); ATT_VST(0, v);
    }
    __syncthreads();
    attn_qk(pA0, pA1, kfrag, qr);
    int k1 = 1, k2 = 2;
#define ATT_STEP(PA0, PA1, PB0, PB1, t) do { \
        if ((t) + 2 < NT) ATT_KST(k2, kg0, kg1); \
        if ((t) + 1 < NT) ATT_VST(((t) + 1) & 1, vg); \
        if ((t) + 3 < NT) { const char* kt = Kh + (size_t)((t) + 3) * 64 * DQK * 2; kg0 = *(const u32x4*)(kt + c0 * 16); if (k1v) kg1 = *(const u32x4*)(kt + c1 * 16); } \
        if ((t) + 2 < NT) vg = *(const u32x4*)(vsrc + (size_t)((t) + 2) * 64); \
        if ((t) + 1 <= tlast) attn_qk(PB0, PB1, kfrag + k1 * KBUF, qr); \
        if ((t) <= tlast) attn_sm_pv(PA0, PA1, o0, o1, l_run, vfrag + ((t) & 1) * VBUF, 64 * (t) + 63 > q0w, q, 64 * (t) + 4 * hi); \
        __syncthreads(); \
        k1 = k2; k2 = (k2 == 2) ? 0 : k2 + 1; \
    } while (0)
#define ATT_FULL(PA0, PA1, PB0, PB1, t) do { \
        bf16x8 vf[8]; u32x4 pw[4]; f32x16 z_; \
        _Pragma("unroll") for (int r = 0; r < 16; ++r) z_[r] = 0.f; \
        float s0_ = 0.f, s1_ = 0.f; \
        _Pragma("unroll") for (int g = 0; g < 12; ++g) {        \
            if (g & 1) PB1 = __builtin_amdgcn_mfma_f32_32x32x16_bf16(kf[g], qr[g >> 1], (g == 1) ? z_ : PB1, 0, 0, 0); \
            else       PB0 = __builtin_amdgcn_mfma_f32_32x32x16_bf16(kf[g], qr[g >> 1], (g == 0) ? z_ : PB0, 0, 0, 0); \
            _Pragma("unroll") for (int e = (32 * g) / 12; e < (32 * (g + 1)) / 12; ++e) { \
                if (e < 16) { PA0[e] = __builtin_amdgcn_exp2f(PA0[e]); s0_ += PA0[e]; } else { PA1[e - 16] = __builtin_amdgcn_exp2f(PA1[e - 16]); s1_ += PA1[e - 16]; } } \
            __builtin_amdgcn_sched_barrier(0); \
        } \
        ATT_KST(k2, kg0, kg1); ATT_VST(((t) + 1) & 1, vg); \
        { const char* kt_ = Kh + (size_t)((t) + 3) * 64 * DQK * 2; kg0 = *(const u32x4*)(kt_ + c0 * 16); if (k1v) kg1 = *(const u32x4*)(kt_ + c1 * 16); } \
        vg = *(const u32x4*)(vsrc + (size_t)((t) + 2) * 64); \
        { const LAS unsigned char* vb_ = vfrag + ((t) & 1) * VBUF; \
          _Pragma("unroll") for (int s = 0; s < 4; ++s) { vf[2 * s] = *(const LAS bf16x8*)(vb_ + s * 32); vf[2 * s + 1] = *(const LAS bf16x8*)(vb_ + 32 * VROW + s * 32); } } \
        __builtin_amdgcn_sched_barrier(0); \
        l_run += s0_ + s1_; \
        _Pragma("unroll") for (int s = 0; s < 2; ++s) { const int b = 8 * s; \
            pw[s].x = cvtpk_s(PA0[b], PA0[b + 1]); pw[s].y = cvtpk_s(PA0[b + 2], PA0[b + 3]); pw[s].z = cvtpk_s(PA0[b + 4], PA0[b + 5]); pw[s].w = cvtpk_s(PA0[b + 6], PA0[b + 7]); \
            pw[s + 2].x = cvtpk_s(PA1[b], PA1[b + 1]); pw[s + 2].y = cvtpk_s(PA1[b + 2], PA1[b + 3]); pw[s + 2].z = cvtpk_s(PA1[b + 4], PA1[b + 5]); pw[s + 2].w = cvtpk_s(PA1[b + 6], PA1[b + 7]); } \
        __builtin_amdgcn_sched_barrier(0); \
        __syncthreads(); \
        __builtin_amdgcn_sched_barrier(0); \
        __builtin_amdgcn_s_setprio(1); \
        _Pragma("unroll") for (int s = 0; s < 4; ++s) { const bf16x8 pa_ = __builtin_bit_cast(bf16x8, pw[s]); \
            o0 = __builtin_amdgcn_mfma_f32_32x32x16_bf16(pa_, vf[2 * s], o0, 0, 0, 0); o1 = __builtin_amdgcn_mfma_f32_32x32x16_bf16(pa_, vf[2 * s + 1], o1, 0, 0, 0); } \
        __builtin_amdgcn_s_setprio(0); \
        { const LAS unsigned char* kb_ = kfrag + k2 * KBUF; \
          _Pragma("unroll") for (int d0 = 0; d0 < 6; ++d0) { kf[2 * d0] = *(const LAS bf16x8*)(kb_ + d0 * 32); kf[2 * d0 + 1] = *(const LAS bf16x8*)(kb_ + 32 * KROW + d0 * 32); } } \
        __builtin_amdgcn_sched_barrier(0); \
        k1 = k2; k2 = (k2 == 2) ? 0 : k2 + 1; \
    } while (0)
    int t = 0;
    bf16x8 kf[12];
    if (qb > 0) {
#pragma unroll
        for (int d0 = 0; d0 < 6; ++d0) { kf[2 * d0] = *(const LAS bf16x8*)(kfrag + KBUF + d0 * 32); kf[2 * d0 + 1] = *(const LAS bf16x8*)(kfrag + KBUF + 32 * KROW + d0 * 32); }
    }
    for (; t < 4 * qb; t += 2) {
        ATT_FULL(pA0, pA1, pB0, pB1, t);
        ATT_FULL(pB0, pB1, pA0, pA1, t + 1);
    }
    for (; t < NT; t += 2) {
        ATT_STEP(pA0, pA1, pB0, pB1, t);
        ATT_STEP(pB0, pB1, pA0, pA1, t + 1);
    }
#undef ATT_FULL
#undef ATT_STEP
#undef ATT_KST
#undef ATT_VST
    l_run += shx(l_run, 32);
    if (hi == 0) sc[r32] = __builtin_amdgcn_rcpf(l_run);
    bf16_t* ob = AO + (size_t)q0w * D + 512 + h * DV + r32;
#pragma unroll
    for (int gq = 0; gq < 4; ++gq) { const f32x4 av = *(const LAS f32x4*)(sc + 8 * gq + 4 * hi);
#pragma unroll
        for (int j = 0; j < 4; ++j) { const int r = 4 * gq + j; const int qrow = crow(r, hi);
            ob[(size_t)qrow * D] = f2bf(o0[r] * av[j]); ob[(size_t)qrow * D + 32] = f2bf(o1[r] * av[j]); } }
    __syncthreads();
}
}

constexpr size_t MiB = 1u << 20;
constexpr size_t WS_SSQ = 0;
constexpr size_t WS_RS = 1 * MiB;
constexpr size_t WS_CTL = 1 * MiB + 512 * 1024, CTL_BYTES = 16384;
constexpr int MISC_OFF = 131072 + 32;
constexpr size_t WS_W = 2 * MiB;
constexpr size_t W_FFN_LAYER = 33 * MiB;
constexpr size_t W_GU_BYTES = 11 * MiB, W_DN_BYTES = (size_t)D * FF * 2;
constexpr size_t WS_WEVEN = WS_W + 4 * W_FFN_LAYER;
constexpr size_t WE_IN = 0, WE_Q = (size_t)ZW * D * 2, WE_K = WE_Q + (size_t)768 * 384 * 2, WE_V = WE_K + (size_t)512 * 256 * 2, WE_OUT = WE_V + (size_t)512 * 256 * 2, WE_STRIDE = 6 * MiB;
static_assert(WE_OUT + (size_t)D * D * 2 <= WE_STRIDE, "even-layer weight map");
constexpr size_t WS_WODD = WS_WEVEN + 2 * WE_STRIDE;
constexpr size_t WO_IN = 0, WO_OUT = 6 * MiB, WO_STRIDE = 8 * MiB;
constexpr size_t WS_XB = WS_WODD + 2 * WO_STRIDE;
constexpr size_t WS_ACT = WS_XB + 32 * MiB;
constexpr size_t WS_H = WS_ACT;
constexpr size_t WS_Z = WS_ACT;
constexpr size_t WS_QP = WS_Z + 40 * MiB;
constexpr size_t WS_KP = WS_QP + 24 * MiB;
constexpr size_t WS_VT = WS_KP + 16 * MiB;
constexpr size_t WS_K = WS_VT + 16 * MiB;
constexpr size_t WS_AO = WS_K + 24 * MiB;
constexpr size_t WS_U = WS_ACT, WS_GB = WS_ACT + 32 * MiB;
constexpr size_t WS_Q = WS_AO + 32 * MiB;
constexpr size_t WS_END = WS_Q + 24 * MiB;

constexpr int LDS_BYTES = 131072 + 8192;

struct Args {
    const float* in[23]; float* out; unsigned char* ws;
};


#define XB_TMO      128
#define XB_XCNT(j)  (256  + 64 * (j))
#define XB_XSUB(j)  (1280 + 64 * (j))
#define XB_XGEN(j)  (2304 + 64 * (j))
#define XB_TOP      3328
#define XB_TOPGEN   3392
#define XCD_BAR_WORDS 3456
#define XB_SPIN_CAP (1u << 20)
__device__ __forceinline__ unsigned xb_ld(unsigned* p)              { return __hip_atomic_load(p, __ATOMIC_RELAXED, __HIP_MEMORY_SCOPE_AGENT); }
__device__ __forceinline__ unsigned xb_add(unsigned* p, unsigned v) { return __hip_atomic_fetch_add(p, v, __ATOMIC_RELAXED, __HIP_MEMORY_SCOPE_AGENT); }
__device__ __forceinline__ unsigned xb_xcc_id() { return (unsigned)__builtin_amdgcn_s_getreg((3 << 11) | 20) & 0xFu; }
#define XB_SPIN(cond, bar) do { unsigned _sp = 0; while (cond) { __builtin_amdgcn_s_sleep(1); \
    if ((++_sp & 255u) == 0u) { if (xb_ld(&(bar)[XB_TMO])) break; if (_sp > XB_SPIN_CAP) { atomicAdd(&(bar)[XB_TMO], 1u); break; } } } } while (0)
struct XcdBarrier { unsigned* bar; unsigned x; volatile LAS unsigned* st; };
__device__ __forceinline__ XcdBarrier xcd_barrier_post(unsigned* bar, volatile LAS unsigned* st, bool t0) {
    XcdBarrier b; b.bar = bar; b.x = xb_xcc_id(); b.st = st;
    if (t0) (void)xb_add(&bar[XB_XCNT(b.x)], 1u);
    return b;
}
__device__ __forceinline__ void xcd_barrier_complete(unsigned* bar, unsigned x, unsigned& nloc, unsigned& nx) {
    const unsigned G = gridDim.x * gridDim.y * gridDim.z;
    unsigned sum, cnt, mine, sp = 0u;
    for (;;) {
        sum = 0u; cnt = 0u; mine = 0u;
#pragma unroll
        for (unsigned j = 0; j < 16; ++j) { const unsigned c = xb_ld(&bar[XB_XCNT(j)]); sum += c; cnt += (c > 0u) ? 1u : 0u; mine = (j == x) ? c : mine; }
        if (sum == G) break;
        __builtin_amdgcn_s_sleep(1);
        if ((++sp & 255u) == 0u) { if (xb_ld(&bar[XB_TMO])) break; if (sp > XB_SPIN_CAP) { atomicAdd(&bar[XB_TMO], 1u); break; } }
    }
    nloc = mine > 0u ? mine : 1u; nx = cnt > 0u ? cnt : 1u;
}
__device__ __forceinline__ void xcd_barrier(const XcdBarrier& b, bool t0) {
    asm volatile("s_waitcnt vmcnt(0)" ::: "memory");
    __syncthreads();
    if (t0) {
        unsigned* bar = b.bar;
        __builtin_amdgcn_s_waitcnt(0);
        unsigned nloc = b.st[0], nx = b.st[1];
        if (nloc == 0u) { xcd_barrier_complete(bar, b.x, nloc, nx); b.st[0] = nloc; b.st[1] = nx; }
        const unsigned old = xb_add(&bar[XB_XSUB(b.x)], 1u);
        const unsigned gen = old / nloc;
        if (old + 1u == (gen + 1u) * nloc) {
            __builtin_amdgcn_fence(__ATOMIC_RELEASE, "agent");
            asm volatile("s_waitcnt vmcnt(0)" ::: "memory");
            const unsigned og = xb_add(&bar[XB_TOP], 1u);
            const unsigned tg = og / nx;
            if (og + 1u == (tg + 1u) * nx) xb_add(&bar[XB_TOPGEN], 1u);
            else XB_SPIN(xb_ld(&bar[XB_TOPGEN]) == tg, bar);
            __builtin_amdgcn_fence(__ATOMIC_ACQUIRE, "agent");
            xb_add(&bar[XB_XGEN(b.x)], 1u);
            asm volatile("s_waitcnt vmcnt(0)" ::: "memory");
        } else {
            XB_SPIN(xb_ld(&bar[XB_XGEN(b.x)]) == gen, bar);
            __builtin_amdgcn_fence(__ATOMIC_ACQUIRE, "agent");
            asm volatile("s_waitcnt vmcnt(0)" ::: "memory");
        }
    }
    __syncthreads();
}
#ifndef PROBE_PRO_REPS
#define PROBE_PRO_REPS 1
#endif
#ifndef PROBE_EWA_REPS
#define PROBE_EWA_REPS 1
#endif
#ifndef PROBE_EWB_REPS
#define PROBE_EWB_REPS 1
#endif
#ifndef PROBE_EWC_REPS
#define PROBE_EWC_REPS 1
#endif
#ifndef PROBE_GU_REPS
#define PROBE_GU_REPS 1
#endif
#ifndef PROBE_MIXA_REPS
#define PROBE_MIXA_REPS 1
#endif
#ifndef PROBE_MIXB_REPS
#define PROBE_MIXB_REPS 1
#endif
#ifndef PROBE_MIXC_REPS
#define PROBE_MIXC_REPS 1
#endif
#ifndef PROBE_SYNC_REPS
#define PROBE_SYNC_REPS 1
#endif
#define GSYNC() do { for (int r_ = 0; r_ < PROBE_SYNC_REPS; ++r_) { XcdBarrier xb_; xb_.bar = (unsigned*)(KARGS()->ws + WS_CTL); xb_.x = xb_xcc_id(); xb_.st = (volatile LAS unsigned*)(lds + MISC_OFF); xcd_barrier(xb_, wave_index(lds) == 0 && lane_id() == 0); } } while (0)
typedef const __attribute__((address_space(4))) Args* KArgP;
#define KARGS() ({ KArgP p_ = (KArgP)__builtin_amdgcn_kernarg_segment_ptr(); asm volatile("" : "+s"(p_)); p_; })
__device__ __forceinline__ void transpose_item(const float* W, int N, int k0, int n0, const float* g, bf16_t* WT, int ldk, int dst_row, LAS float* scr, int lane) {
    float v[32];
    const float* wp = W + (size_t)(k0 + (lane >> 5)) * N + n0 + (lane & 31);
#pragma unroll
    for (int i = 0; i < 32; ++i) v[i] = wp[(size_t)(2 * i) * N];
    if (g) {
        const float* gp = g + k0 + (lane >> 5);
#pragma unroll
        for (int i = 0; i < 32; ++i) v[i] *= gp[2 * i];
    }
#pragma unroll
    for (int i = 0; i < 32; ++i) scr[(2 * i + (lane >> 5)) * 33 + (lane & 31)] = v[i];
    asm volatile("s_waitcnt lgkmcnt(0)" ::: "memory");
    const int c = lane & 7;
#pragma unroll
    for (int j = 0; j < 4; ++j) { const int n = (lane >> 3) + 8 * j; const LAS float* s = scr + (8 * c) * 33 + n;
        u32x4 o; o.x = cvt_pk_bf16(s[0 * 33], s[1 * 33]); o.y = cvt_pk_bf16(s[2 * 33], s[3 * 33]); o.z = cvt_pk_bf16(s[4 * 33], s[5 * 33]); o.w = cvt_pk_bf16(s[6 * 33], s[7 * 33]);
        *(u32x4*)(WT + (size_t)(dst_row + n) * ldk + k0 + 8 * c) = o; }
    asm volatile("s_waitcnt lgkmcnt(0)" ::: "memory");
}
__device__ __forceinline__ float wave_sum(float v) {
#pragma unroll
    for (int o = 1; o < 64; o <<= 1) v += shx(v, o);
    return v;
}

constexpr int I_FFN_M = 1408, I_FFN = 3 * I_FFN_M, I_LAYER = 2 * I_FFN, I_ALLFFN = 4 * I_LAYER;
constexpr int I_EIN = 16 * 37, I_EQ = 6 * 24, I_EKV = 4 * 32, I_EOUT = 8 * 32, I_EVEN = I_EIN + I_EQ + I_EKV + I_EOUT;
constexpr int I_OIN = 16 * 96, I_OOUT = 16 * 32, I_ODD = I_OIN + I_OOUT;
__device__ __forceinline__ void convert_items(KArgP ap, LAS unsigned char* lds, int lo, int hi, int w, int nw, int wave, int lane) {
    unsigned char* ws = ap->ws;
    LAS float* scr = (LAS float*)(lds + wave * 16384);
    for (int it = lo + w; it < hi; it += nw) {
        int r = it;
        if (r < I_ALLFFN) {
            const int L = r / I_LAYER; r %= I_LAYER; const int f = r / I_FFN; r %= I_FFN; const int mtx = r / I_FFN_M; r %= I_FFN_M;
            bf16_t* wgu = (bf16_t*)(ws + WS_W + L * W_FFN_LAYER + f * (W_GU_BYTES + W_DN_BYTES)); bf16_t* wdn = (bf16_t*)((unsigned char*)wgu + W_GU_BYTES);
            const float* g = ap->in[f == 0 ? 1 : 6] + (size_t)L * D;
            if (mtx < 2) {
                const float* W = ap->in[(f == 0 ? 2 : 7) + mtx] + (size_t)L * D * FF;
                const int kb = r / 88, nb = r % 88, n0 = 32 * nb;
                transpose_item(W, FF, 64 * kb, n0, g, wgu, D, 256 * (n0 / 128) + (n0 % 128) + 128 * mtx, scr, lane);
            } else {
                const float* W = ap->in[f == 0 ? 4 : 9] + (size_t)L * FF * D;
                const int kb = r / 32, nb = r % 32;
                transpose_item(W, D, 64 * kb, 32 * nb, nullptr, wdn, FF, 32 * nb, scr, lane);
            }
            continue;
        }
        r -= I_ALLFFN;
        if (r < 2 * I_EVEN) {
            const int i = r / I_EVEN; r %= I_EVEN; const int L = 2 * i;
            unsigned char* wb = ws + WS_WEVEN + i * WE_STRIDE;
            if (r < I_EIN) { const int kb = r / 37, nb = r % 37;
                transpose_item(ap->in[10] + (size_t)i * D * 1184, 1184, 64 * kb, 32 * nb, ap->in[5] + (size_t)L * D, (bf16_t*)(wb + WE_IN), D, 32 * nb, scr, lane); continue; }
            r -= I_EIN;
            if (r < I_EQ) { const int kb = r / 24, nb = r % 24;
                transpose_item(ap->in[12] + (size_t)i * 384 * 768, 768, 64 * kb, 32 * nb, ap->in[11] + (size_t)i * 384, (bf16_t*)(wb + WE_Q), 384, 32 * nb, scr, lane); continue; }
            r -= I_EQ;
            if (r < I_EKV) { const int kb = r / 32, nb = r % 32, n0 = 32 * nb, hh = n0 / 128, w = n0 % 128;
                bf16_t* dst = (bf16_t*)(wb + (w < 64 ? WE_K : WE_V));
                transpose_item(ap->in[14] + (size_t)i * 256 * 1024, 1024, 64 * kb, n0, ap->in[13] + (size_t)i * 256, dst, 256, hh * 64 + (w & 63), scr, lane); continue; }
            r -= I_EKV;
            { const int kb = r / 32, nb = r % 32;
              transpose_item(ap->in[19] + (size_t)i * D * D, D, 512 + 64 * kb, 32 * nb, nullptr, (bf16_t*)(wb + WE_OUT), D, 32 * nb, scr, lane); }
            continue;
        }
        r -= 2 * I_EVEN;
        {
            const int i = r / I_ODD; r %= I_ODD; const int L = 2 * i + 1;
            unsigned char* wb = ws + WS_WODD + i * WO_STRIDE;
            if (r < I_OIN) { const int kb = r / 96, nb = r % 96, n0 = 32 * nb, seg = n0 / 1024, j = n0 % 1024;
                const int drow = (seg == 0) ? 2048 + j : 256 * (j / 128) + (j % 128) + (seg == 2 ? 128 : 0);
                transpose_item(ap->in[20] + (size_t)i * D * 3072, 3072, 64 * kb, n0, ap->in[5] + (size_t)L * D, (bf16_t*)(wb + WO_IN), D, drow, scr, lane); continue; }
            r -= I_OIN;
            { const int kb = r / 32, nb = r % 32;
              transpose_item(ap->in[22] + (size_t)i * D * D, D, 64 * kb, 32 * nb, nullptr, (bf16_t*)(wb + WO_OUT), D, 32 * nb, scr, lane); }
        }
    }
}
__device__ __forceinline__ void fold_jobs(KArgP ap, LAS unsigned char* lds, int i, int w, int nw, int wave, int lane) {
    unsigned char* ws = ap->ws;
    LAS float* scr = (LAS float*)(lds + wave * 16384);
    {
        const int gt = w * 64 + lane, ngt = nw * 64;
        for (int job = w; job < 1024; job += nw) {
            const int gg = (job >> 8) & 3, kch = (job >> 4) & 15, nb = job & 15, n = nb * 64 + lane;
            const float* wp = ap->in[17] + (size_t)i * 4 * 128 * 128 + ((size_t)gg * 128 + kch * 8) * 128;
            const float* sc = ap->in[18] + (size_t)i * 512 + gg * 128;
            const float* wo = ap->in[19] + (size_t)i * D * D + (size_t)gg * 128 * D + n;
            {
                f32x4 pv[4], sv[4];
#pragma unroll
                for (int q = 0; q < 4; ++q) { const int idx = (q * 64 + lane) * 4; pv[q] = *(const f32x4*)(wp + idx); sv[q] = *(const f32x4*)(sc + (idx & 127)); }
#pragma unroll
                for (int q = 0; q < 4; ++q) *(LAS f32x4*)(scr + (q * 64 + lane) * 4) = pv[q] * sv[q];
            }
            asm volatile("s_waitcnt lgkmcnt(0)" ::: "memory");
            float acc[8];
#pragma unroll
            for (int j = 0; j < 8; ++j) acc[j] = 0.f;
#pragma unroll 1
            for (int c0 = 0; c0 < 128; c0 += 16) {
                float wv[16];
#pragma unroll
                for (int ii = 0; ii < 16; ++ii) wv[ii] = wo[(size_t)(c0 + ii) * D];
                asm volatile("" ::: "memory");
#pragma unroll
                for (int ii = 0; ii < 16; ii += 4)
#pragma unroll
                    for (int j = 0; j < 8; ++j) { const f32x4 wq = *(const LAS f32x4*)(scr + j * 128 + c0 + ii);
                        acc[j] += (wq[0] * wv[ii] + wq[1] * wv[ii + 1]) + (wq[2] * wv[ii + 2] + wq[3] * wv[ii + 3]); }
            }
            u32x4 o; o.x = cvt_pk_bf16(acc[0], acc[1]); o.y = cvt_pk_bf16(acc[2], acc[3]); o.z = cvt_pk_bf16(acc[4], acc[5]); o.w = cvt_pk_bf16(acc[6], acc[7]);
            *(u32x4*)((bf16_t*)(ws + WS_WEVEN + i * WE_STRIDE + WE_OUT) + (size_t)n * D + gg * 128 + kch * 8) = o;
            asm volatile("s_waitcnt lgkmcnt(0)" ::: "memory");
        }
        unsigned zv = 0u; asm volatile("" : "+v"(zv));
        for (int idx = gt; idx < 96 * 128; idx += ngt)
            ((u32x4*)(ws + WS_WEVEN + i * WE_STRIDE + WE_IN + (size_t)1184 * D * 2))[idx] = (u32x4){zv, zv, zv, zv};
    }
}
__device__ __forceinline__ void x_init(KArgP ap, int gw, int ngw, int lane) {
    unsigned char* ws = ap->ws;
    {
        const float* __restrict__ x = ap->in[0]; bf16_t* __restrict__ xb = (bf16_t*)(ws + WS_XB); float* __restrict__ ssq = (float*)(ws + WS_SSQ);
#pragma unroll 2
        for (int m = gw; m < S; m += ngw) {
            const f32x4* xr = (const f32x4*)(x + (size_t)m * D) + lane; float s = 0.f;
            u32x2* o8 = (u32x2*)(xb + (size_t)m * D) + lane;
#pragma unroll
            for (int j = 0; j < 4; ++j) { const f32x4 v = xr[64 * j]; s += (v[0] * v[0] + v[1] * v[1]) + (v[2] * v[2] + v[3] * v[3]); u32x2 w; w.x = cvt_pk_bf16(v[0], v[1]); w.y = cvt_pk_bf16(v[2], v[3]); o8[64 * j] = w; }
            s = wave_sum(s);
            if (lane < 16) ssq[(size_t)m * 16 + lane] = (lane == 0) ? s : 0.f;
        }
    }
}

__device__ __forceinline__ void convert_layer_half(KArgP ap, LAS unsigned char* lds, int Ln, int f, int w, int nw, int wave, int lane) {
    convert_items(ap, lds, Ln * I_LAYER + f * I_FFN, Ln * I_LAYER + (f + 1) * I_FFN, w, nw, wave, lane);
    if (f == 0) {
        const int i = Ln >> 1;
        if ((Ln & 1) == 0) { convert_items(ap, lds, I_ALLFFN + i * I_EVEN, I_ALLFFN + (i + 1) * I_EVEN, w, nw, wave, lane); fold_jobs(ap, lds, i, w, nw, wave, lane); }
        else convert_items(ap, lds, I_ALLFFN + 2 * I_EVEN + i * I_ODD, I_ALLFFN + 2 * I_EVEN + (i + 1) * I_ODD, w, nw, wave, lane);
    }
}
__device__ __forceinline__ void convert_chunk(KArgP ap, LAS unsigned char* lds, int k, int w, int nw, int wave, int lane) {
    if (k == 1) convert_items(ap, lds, 2 * I_FFN_M, I_LAYER, w, nw, wave, lane);
    else if (k <= 7) convert_layer_half(ap, lds, k >> 1, k & 1, w, nw, wave, lane);
}
__device__ __forceinline__ void prologue(KArgP ap, LAS unsigned char* lds, int gw, int ngw, int wave, int lane) {
    convert_items(ap, lds, 0, 2 * I_FFN_M, gw, ngw, wave, lane);
    convert_items(ap, lds, I_ALLFFN, I_ALLFFN + I_EVEN, gw, ngw, wave, lane);
    fold_jobs(ap, lds, 0, gw, ngw, wave, lane);
    x_init(ap, gw, ngw, lane);
}

__device__ __forceinline__ void pool_stats_phase(const bf16_t* __restrict__ Z, bf16_t* __restrict__ AO, float* __restrict__ RS, int gw, int ngw, int lane) {
    const int c0 = lane * 8, w = 2 << (lane >> 4);
#pragma unroll 2
    for (int t = gw; t < S; t += ngw) {
        const bf16_t* zr = Z + (size_t)t * ZW;
        const unsigned* pq = (const unsigned*)(zr + 512 + lane * 6); const unsigned qa = pq[0], qb = pq[1], qc = pq[2];
        const unsigned* pk = (const unsigned*)(zr + 896 + lane * 4); const unsigned ka = pk[0], kb = pk[1];
        u32x4 v[16];
#pragma unroll
        for (int j = 0; j < 16; ++j) { const int rr = (t - j) > 0 ? (t - j) : 0; v[j] = *(const u32x4*)(Z + (size_t)rr * ZW + c0); }
        { float s = bf_lo(qa) * bf_lo(qa) + bf_hi(qa) * bf_hi(qa) + bf_lo(qb) * bf_lo(qb) + bf_hi(qb) * bf_hi(qb) + bf_lo(qc) * bf_lo(qc) + bf_hi(qc) * bf_hi(qc);
          s = wave_sum(s); if (lane == 0) RS[(size_t)t * 2] = __builtin_amdgcn_rsqf(s * (1.0f / 384.0f) + EPS); }
        { float s = bf_lo(ka) * bf_lo(ka) + bf_hi(ka) * bf_hi(ka) + bf_lo(kb) * bf_lo(kb) + bf_hi(kb) * bf_hi(kb);
          s = wave_sum(s); if (lane == 0) RS[(size_t)t * 2 + 1] = __builtin_amdgcn_rsqf(s * (1.0f / 256.0f) + EPS); }
        float a0 = 0.f, a1 = 0.f, a2 = 0.f, a3 = 0.f, a4 = 0.f, a5 = 0.f, a6 = 0.f, a7 = 0.f;
#pragma unroll
        for (int j = 0; j < 16; ++j) {
            const float mk = (j < w && j <= t) ? 1.0f : 0.0f;
            a0 += mk * bf_lo(v[j].x); a1 += mk * bf_hi(v[j].x); a2 += mk * bf_lo(v[j].y); a3 += mk * bf_hi(v[j].y);
            a4 += mk * bf_lo(v[j].z); a5 += mk * bf_hi(v[j].z); a6 += mk * bf_lo(v[j].w); a7 += mk * bf_hi(v[j].w);
        }
        const float ic = 1.0f / (float)((t + 1 < w) ? (t + 1) : w);
        const u32x4 cur = v[0];
        u32x4 o; o.x = cvt_pk_bf16(a0 * ic - bf_lo(cur.x), a1 * ic - bf_hi(cur.x)); o.y = cvt_pk_bf16(a2 * ic - bf_lo(cur.y), a3 * ic - bf_hi(cur.y));
        o.z = cvt_pk_bf16(a4 * ic - bf_lo(cur.z), a5 * ic - bf_hi(cur.z)); o.w = cvt_pk_bf16(a6 * ic - bf_lo(cur.w), a7 * ic - bf_hi(cur.w));
        *(u32x4*)(AO + (size_t)t * D + c0) = o;
    }
}

__device__ __forceinline__ void qk_prep_phase(const bf16_t* __restrict__ QP, const bf16_t* __restrict__ KP, const bf16_t* __restrict__ Z, const float* __restrict__ qhn, const float* __restrict__ khn, bf16_t* __restrict__ Q, bf16_t* __restrict__ K, int gt, int ngt) {
    const float QSC = 0.10206207261596577f * 1.4426950408889634f;
    const int q4 = gt & 3;
    for (int item = gt >> 2; item < S * NH; item += ngt >> 2) {
        const int t = item >> 3, h = item & 7;
        u32x4 qv[3], kv[3];
        { const u32x4* p = (const u32x4*)(QP + (size_t)t * 768 + h * 96) + q4; qv[0] = p[0]; qv[1] = p[4]; qv[2] = p[8]; }
        { const u32x4* p = (const u32x4*)(KP + (size_t)t * 512 + h * 64) + q4; kv[0] = p[0]; kv[1] = p[4]; kv[2] = ((const u32x4*)(Z + (size_t)t * ZW + 1152))[q4]; }
        float cs[8], sn[8];
#pragma unroll
        for (int j = 0; j < 8; ++j) {
            const int i = 8 * (q4 & 1) + j;
            const float inv_freq = exp2f(-(float)i * (13.287712379549449f / 16.0f));
            const double rev = (double)t * (double)inv_freq * 0.15915494309189535;
            const float fr = (float)(rev - rint(rev));
            cs[j] = __builtin_amdgcn_cosf(fr); sn[j] = __builtin_amdgcn_sinf(fr);
        }
#pragma unroll
        for (int which = 0; which < 2; ++which) {
            const u32x4* v = which == 0 ? qv : kv; const float* gn = which == 0 ? qhn : khn;
            float ss = 0.f;
#pragma unroll
            for (int c = 0; c < 3; ++c) { const u32x4 x = v[c];
                ss += (bf_lo(x.x) * bf_lo(x.x) + bf_hi(x.x) * bf_hi(x.x)) + (bf_lo(x.y) * bf_lo(x.y) + bf_hi(x.y) * bf_hi(x.y)) + (bf_lo(x.z) * bf_lo(x.z) + bf_hi(x.z) * bf_hi(x.z)) + (bf_lo(x.w) * bf_lo(x.w) + bf_hi(x.w) * bf_hi(x.w)); }
            ss += shx(ss, 1); ss += shx(ss, 2);
            const float rs = __builtin_amdgcn_rsqf(ss * (1.0f / 96.0f) + EPS) * (which == 0 ? QSC : 1.0f);
            u32x4* dst = (u32x4*)((which == 0 ? Q : K) + ((size_t)h * S + t) * DQK) + q4;
#pragma unroll
            for (int c = 0; c < 2; ++c) {
                const u32x4 x = v[c]; const float* g = gn + 8 * q4 + 32 * c; const f32x4 g0 = *(const f32x4*)g, g1 = *(const f32x4*)(g + 4);
                u32x4 o; o.x = cvt_pk_bf16(bf_lo(x.x) * rs * g0[0], bf_hi(x.x) * rs * g0[1]); o.y = cvt_pk_bf16(bf_lo(x.y) * rs * g0[2], bf_hi(x.y) * rs * g0[3]);
                o.z = cvt_pk_bf16(bf_lo(x.z) * rs * g1[0], bf_hi(x.z) * rs * g1[1]); o.w = cvt_pk_bf16(bf_lo(x.w) * rs * g1[2], bf_hi(x.w) * rs * g1[3]);
                dst[4 * c] = o;
            }
            {
                const u32x4 xo = v[2];
                u32x4 xp; xp.x = shx(xo.x, 2); xp.y = shx(xo.y, 2); xp.z = shx(xo.z, 2); xp.w = shx(xo.w, 2);
                const float* go = gn + 64 + 8 * q4; const float* gp = gn + 64 + 8 * (q4 ^ 2);
                const f32x4 go0 = *(const f32x4*)go, go1 = *(const f32x4*)(go + 4), gp0 = *(const f32x4*)gp, gp1 = *(const f32x4*)(gp + 4);
                const float a[8] = {bf_lo(xo.x) * rs * go0[0], bf_hi(xo.x) * rs * go0[1], bf_lo(xo.y) * rs * go0[2], bf_hi(xo.y) * rs * go0[3], bf_lo(xo.z) * rs * go1[0], bf_hi(xo.z) * rs * go1[1], bf_lo(xo.w) * rs * go1[2], bf_hi(xo.w) * rs * go1[3]};
                const float b[8] = {bf_lo(xp.x) * rs * gp0[0], bf_hi(xp.x) * rs * gp0[1], bf_lo(xp.y) * rs * gp0[2], bf_hi(xp.y) * rs * gp0[3], bf_lo(xp.z) * rs * gp1[0], bf_hi(xp.z) * rs * gp1[1], bf_lo(xp.w) * rs * gp1[2], bf_hi(xp.w) * rs * gp1[3]};
                const float sg = (q4 < 2) ? -1.0f : 1.0f;
                float y[8];
#pragma unroll
                for (int j = 0; j < 8; ++j) y[j] = a[j] * cs[j] + sg * b[j] * sn[j];
                u32x4 o; o.x = cvt_pk_bf16(y[0], y[1]); o.y = cvt_pk_bf16(y[2], y[3]); o.z = cvt_pk_bf16(y[4], y[5]); o.w = cvt_pk_bf16(y[6], y[7]);
                dst[8] = o;
            }
        }
    }
}

__device__ __forceinline__ void conv_phase(const bf16_t* __restrict__ U, const bf16_t* __restrict__ GB, const float* __restrict__ cw, bf16_t* __restrict__ AO, int gt, int ngt) {
    const int c0 = (gt & 127) * 8;
    const f32x4 wa0 = *(const f32x4*)(cw + c0), wa1 = *(const f32x4*)(cw + c0 + 4);
    const f32x4 wb0 = *(const f32x4*)(cw + D + c0), wb1 = *(const f32x4*)(cw + D + c0 + 4);
    const f32x4 wc0 = *(const f32x4*)(cw + 2 * D + c0), wc1 = *(const f32x4*)(cw + 2 * D + c0 + 4);
#pragma unroll 4
    for (int idx = gt; idx < S * 128; idx += ngt) {
        const int t = idx >> 7;
        const int t1 = t >= 1 ? t - 1 : 0, t2 = t >= 2 ? t - 2 : 0;
        const float m1 = t >= 1 ? 1.0f : 0.0f, m2 = t >= 2 ? 1.0f : 0.0f;
        const u32x4 u0 = *(const u32x4*)(U + (size_t)t * D + c0);
        const u32x4 u1 = *(const u32x4*)(U + (size_t)t1 * D + c0);
        const u32x4 u2 = *(const u32x4*)(U + (size_t)t2 * D + c0);
        const u32x4 gb = *(const u32x4*)(GB + (size_t)t * D + c0);
        float y[8];
        y[0] = m2 * wa0[0] * bf_lo(u2.x) + m1 * wb0[0] * bf_lo(u1.x) + wc0[0] * bf_lo(u0.x);
        y[1] = m2 * wa0[1] * bf_hi(u2.x) + m1 * wb0[1] * bf_hi(u1.x) + wc0[1] * bf_hi(u0.x);
        y[2] = m2 * wa0[2] * bf_lo(u2.y) + m1 * wb0[2] * bf_lo(u1.y) + wc0[2] * bf_lo(u0.y);
        y[3] = m2 * wa0[3] * bf_hi(u2.y) + m1 * wb0[3] * bf_hi(u1.y) + wc0[3] * bf_hi(u0.y);
        y[4] = m2 * wa1[0] * bf_lo(u2.z) + m1 * wb1[0] * bf_lo(u1.z) + wc1[0] * bf_lo(u0.z);
        y[5] = m2 * wa1[1] * bf_hi(u2.z) + m1 * wb1[1] * bf_hi(u1.z) + wc1[1] * bf_hi(u0.z);
        y[6] = m2 * wa1[2] * bf_lo(u2.w) + m1 * wb1[2] * bf_lo(u1.w) + wc1[2] * bf_lo(u0.w);
        y[7] = m2 * wa1[3] * bf_hi(u2.w) + m1 * wb1[3] * bf_hi(u1.w) + wc1[3] * bf_hi(u0.w);
        u32x4 o; o.x = cvt_pk_bf16(bf_lo(gb.x) * y[0], bf_hi(gb.x) * y[1]); o.y = cvt_pk_bf16(bf_lo(gb.y) * y[2], bf_hi(gb.y) * y[3]);
        o.z = cvt_pk_bf16(bf_lo(gb.z) * y[4], bf_hi(gb.z) * y[5]); o.w = cvt_pk_bf16(bf_lo(gb.w) * y[6], bf_hi(gb.w) * y[7]);
        *(u32x4*)(AO + (size_t)t * D + c0) = o;
    }
}

struct Ids { int lane, wave, vcu, gw, ngw, gt, ngt, G, bx; };
__device__ __forceinline__ Ids make_ids(LAS unsigned char* lds) {
    Ids d; d.wave = wave_index(lds); int tid = d.wave * 64 + lane_id(); asm volatile("" : "+v"(tid));
    d.lane = tid & 63;
    d.G = gridDim.x; d.bx = blockIdx.x; asm volatile("" : "+s"(d.G), "+s"(d.bx));
    d.vcu = (d.G % 8 == 0) ? (d.bx % 8) * (d.G / 8) + d.bx / 8 : d.bx;
    d.gw = d.vcu * 8 + d.wave; d.ngw = d.G * 8; d.gt = d.gw * 64 + d.lane; d.ngt = d.ngw * 64;
    return d;
}

__global__ void __launch_bounds__(512, 2) fwd_megakernel(Args a_unused) {
    extern __shared__ __attribute__((aligned(16))) unsigned char lds_raw[];
    LAS unsigned char* lds = (LAS unsigned char*)lds_raw;

    {
        const int w_ = __builtin_amdgcn_readfirstlane((int)threadIdx.x >> 6);
        if (lane_id() == 0) ((volatile LAS int*)(lds + WTAB_OFF))[hw_slot()] = w_;
        if (w_ == 0 && lane_id() < 2) ((volatile LAS unsigned*)(lds + MISC_OFF))[lane_id()] = 0u;
    }
    __syncthreads();
    (void)xcd_barrier_post((unsigned*)(KARGS()->ws + WS_CTL), (volatile LAS unsigned*)(lds + MISC_OFF), wave_index(lds) == 0 && lane_id() == 0);
    { const Ids d = make_ids(lds); KArgP k = KARGS();
      for (int rep = 0; rep < PROBE_PRO_REPS; ++rep) prologue(k, lds, d.gw, d.ngw, d.wave, d.lane); }
    if (a_unused.ws == nullptr) cg::this_grid().sync();
    GSYNC();

#pragma unroll 1
    for (int L = 0; L < DEPTH; ++L) {
#pragma unroll 1
        for (int f = 0; f < 2; ++f) {
            {
                KArgP k = KARGS(); unsigned char* ws = k->ws;
                const bf16_t* wgu = (const bf16_t*)(ws + WS_W + L * W_FFN_LAYER + f * (W_GU_BYTES + W_DN_BYTES));
                pg8::Gemm g{(const bf16_t*)(ws + WS_XB), wgu, S, 2 * FF, D, D, D}; pg8::StaticOrder so; so.init(S, 2 * FF, gridDim.x, blockIdx.x);
                pg8::EpiSwiGLU E{(bf16_t*)(ws + WS_H), (const float*)(ws + WS_SSQ), lds};
                for (int rep = 0; rep < PROBE_GU_REPS; ++rep) pg8::gemm_phase<pg8::EpiSwiGLU>(lds, g, so, E);
                {
                    const Ids d = make_ids(lds); const int half = d.G / 2;
                    if (d.bx >= half) convert_chunk(KARGS(), lds, 2 * L + f + 1, (d.bx - half) * 8 + d.wave, (d.G - half) * 8, d.wave, d.lane);
                }
            }
            GSYNC();
            {
                KArgP k = KARGS(); unsigned char* ws = k->ws; float* out = k->out;
                const bf16_t* wdn = (const bf16_t*)(ws + WS_W + L * W_FFN_LAYER + f * (W_GU_BYTES + W_DN_BYTES) + W_GU_BYTES);
                pg8::Gemm g{(const bf16_t*)(ws + WS_H), wdn, S, D, FF, FF, FF}; pg8::StaticOrder so; so.init(S, D, gridDim.x, blockIdx.x);
                pg8::EpiResid E{(L == DEPTH - 1 && f == 1) ? out : (float*)nullptr, (bf16_t*)(ws + WS_XB), (float*)(ws + WS_SSQ), 0.5f};
                pg8::gemm_phase<pg8::EpiResid>(lds, g, so, E);
#ifdef PROBE_DN
                { GSYNC(); pg8::EpiResid E2{(float*)nullptr, (bf16_t*)(ws + WS_XB), (float*)(ws + WS_SSQ), 0.0f}; pg8::gemm_phase<pg8::EpiResid>(lds, g, so, E2); }
#endif
            }
            GSYNC();
            if (f == 1) break;
            const int i = L >> 1;
            if ((L & 1) == 0) {
                {
                    KArgP k = KARGS(); unsigned char* ws = k->ws; unsigned char* wb = ws + WS_WEVEN + i * WE_STRIDE;
                    pg8::Gemm g{(const bf16_t*)(ws + WS_XB), (const bf16_t*)(wb + WE_IN), S, ZW, D, D, D}; pg8::StaticOrder so; so.init(S, ZW, gridDim.x, blockIdx.x);
                    pg8::EpiRowBf16<0> E{(bf16_t*)(ws + WS_Z), ZW, (const float*)(ws + WS_SSQ), 0, lds};
                    for (int rep_ = 0; rep_ < PROBE_MIXA_REPS; ++rep_) pg8::gemm_phase<pg8::EpiRowBf16<0>>(lds, g, so, E);
                }
                GSYNC();
                { KArgP k = KARGS(); unsigned char* ws = k->ws; const Ids d = make_ids(lds);
                  for (int rep = 0; rep < PROBE_EWA_REPS; ++rep) pool_stats_phase((const bf16_t*)(ws + WS_Z), (bf16_t*)(ws + WS_AO), (float*)(ws + WS_RS), d.gw, d.ngw, d.lane); }
                GSYNC();
                {
                    KArgP k = KARGS(); unsigned char* ws = k->ws; unsigned char* wb = ws + WS_WEVEN + i * WE_STRIDE;
                    pg8::Gemm g{(const bf16_t*)(ws + WS_Z) + 512, (const bf16_t*)(wb + WE_Q), S, 768, 384, ZW, 384}; pg8::StaticOrder so; so.init(S, 768, gridDim.x, blockIdx.x);
                    pg8::EpiRowBf16<1> E{(bf16_t*)(ws + WS_QP), 768, (const float*)(ws + WS_RS), 0, lds};
                    for (int rep_ = 0; rep_ < PROBE_MIXB_REPS; ++rep_) pg8::gemm_phase<pg8::EpiRowBf16<1>>(lds, g, so, E);
                }
                {
                    KArgP k = KARGS(); unsigned char* ws = k->ws; unsigned char* wb = ws + WS_WEVEN + i * WE_STRIDE;
                    pg8::Gemm g{(const bf16_t*)(ws + WS_Z) + 896, (const bf16_t*)(wb + WE_K), S, 512, 256, ZW, 256}; pg8::StaticOrder so; so.init(S, 512, gridDim.x, (blockIdx.x + gridDim.x / 2) % gridDim.x);
                    pg8::EpiRowBf16<1> E{(bf16_t*)(ws + WS_KP), 512, (const float*)(ws + WS_RS), 1, lds};
                    for (int rep_ = 0; rep_ < PROBE_MIXB_REPS; ++rep_) pg8::gemm_phase<pg8::EpiRowBf16<1>>(lds, g, so, E);
                }
                {
                    KArgP k = KARGS(); unsigned char* ws = k->ws; unsigned char* wb = ws + WS_WEVEN + i * WE_STRIDE;
                    pg8::Gemm g{(const bf16_t*)(wb + WE_V), (const bf16_t*)(ws + WS_Z) + 896, 512, S, 256, 256, ZW}; pg8::StaticOrder so; so.init(512, S, gridDim.x, (blockIdx.x + 3 * gridDim.x / 4) % gridDim.x);
                    pg8::EpiColBf16 E{(bf16_t*)(ws + WS_VT), S, (const float*)(ws + WS_RS)};
                    for (int rep_ = 0; rep_ < PROBE_MIXB_REPS; ++rep_) pg8::gemm_phase<pg8::EpiColBf16>(lds, g, so, E);
                }
                GSYNC();
                { KArgP k = KARGS(); unsigned char* ws = k->ws; const Ids d = make_ids(lds);
                  for (int rep = 0; rep < PROBE_EWB_REPS; ++rep) qk_prep_phase((const bf16_t*)(ws + WS_QP), (const bf16_t*)(ws + WS_KP), (const bf16_t*)(ws + WS_Z), k->in[15] + (size_t)i * DQK, k->in[16] + (size_t)i * DQK,
                                (bf16_t*)(ws + WS_Q), (bf16_t*)(ws + WS_K), d.gt, d.ngt); }
                GSYNC();
                {
                    KArgP k = KARGS(); unsigned char* ws = k->ws; const Ids d = make_ids(lds);
                    const int h = (d.vcu >> 5) & 7, s = d.vcu & 31;
#ifndef PROBE_ATT_REPS
#define PROBE_ATT_REPS 1
#endif
                    if (d.vcu < 256) for (int rep = 0; rep < PROBE_ATT_REPS; ++rep) {
                        att::attn_unit<0>(h, 63 - s, (const bf16_t*)(ws + WS_Q), (const bf16_t*)(ws + WS_K), (const bf16_t*)(ws + WS_VT), (bf16_t*)(ws + WS_AO), lds);
                        att::attn_unit<0>(h, s, (const bf16_t*)(ws + WS_Q), (const bf16_t*)(ws + WS_K), (const bf16_t*)(ws + WS_VT), (bf16_t*)(ws + WS_AO), lds);
                    }
#ifdef PROBE_ATT_VAR
                    if (d.vcu < 256) {
                        att::attn_unit<PROBE_ATT_VAR>(h, 63 - s, (const bf16_t*)(ws + WS_Q), (const bf16_t*)(ws + WS_K), (const bf16_t*)(ws + WS_VT), (bf16_t*)(ws + WS_QP), lds);
                        att::attn_unit<PROBE_ATT_VAR>(h, s, (const bf16_t*)(ws + WS_Q), (const bf16_t*)(ws + WS_K), (const bf16_t*)(ws + WS_VT), (bf16_t*)(ws + WS_QP), lds);
                    }
#endif
                }
                GSYNC();
                {
                    KArgP k = KARGS(); unsigned char* ws = k->ws; float* out = k->out; unsigned char* wb = ws + WS_WEVEN + i * WE_STRIDE;
                    pg8::Gemm g{(const bf16_t*)(ws + WS_AO), (const bf16_t*)(wb + WE_OUT), S, D, D, D, D}; pg8::StaticOrder so; so.init(S, D, gridDim.x, blockIdx.x);
                    pg8::EpiResid E{(float*)nullptr, (bf16_t*)(ws + WS_XB), (float*)(ws + WS_SSQ), 1.0f};
                    pg8::gemm_phase<pg8::EpiResid>(lds, g, so, E);
#ifdef PROBE_MIXOUT
                    { pg8::EpiResid E2{(float*)nullptr, (bf16_t*)(ws + WS_XB), (float*)(ws + WS_SSQ), 0.0f}; pg8::gemm_phase<pg8::EpiResid>(lds, g, so, E2); }
#endif
                }
                GSYNC();
            } else {
                {
                    KArgP k = KARGS(); unsigned char* ws = k->ws; unsigned char* wb = ws + WS_WODD + i * WO_STRIDE;
                    pg8::Gemm g{(const bf16_t*)(ws + WS_XB), (const bf16_t*)(wb + WO_IN), S, 3 * D, D, D, D}; pg8::StaticOrder so; so.init(S, 3 * D, gridDim.x, blockIdx.x);
                    pg8::EpiConvIn E{(bf16_t*)(ws + WS_U), (bf16_t*)(ws + WS_GB), (const float*)(ws + WS_SSQ), lds};
                    for (int rep_ = 0; rep_ < PROBE_MIXC_REPS; ++rep_) pg8::gemm_phase<pg8::EpiConvIn>(lds, g, so, E);
                }
                GSYNC();
                { KArgP k = KARGS(); unsigned char* ws = k->ws; const Ids d = make_ids(lds);
                  for (int rep = 0; rep < PROBE_EWC_REPS; ++rep) conv_phase((const bf16_t*)(ws + WS_U), (const bf16_t*)(ws + WS_GB), k->in[21] + (size_t)i * 3 * D, (bf16_t*)(ws + WS_AO), d.gt, d.ngt); }
                GSYNC();
                {
                    KArgP k = KARGS(); unsigned char* ws = k->ws; float* out = k->out; unsigned char* wb = ws + WS_WODD + i * WO_STRIDE;
                    pg8::Gemm g{(const bf16_t*)(ws + WS_AO), (const bf16_t*)(wb + WO_OUT), S, D, D, D, D}; pg8::StaticOrder so; so.init(S, D, gridDim.x, blockIdx.x);
                    pg8::EpiResid E{(float*)nullptr, (bf16_t*)(ws + WS_XB), (float*)(ws + WS_SSQ), 1.0f};
                    pg8::gemm_phase<pg8::EpiResid>(lds, g, so, E);
#ifdef PROBE_MIXOUT
                    { pg8::EpiResid E2{(float*)nullptr, (bf16_t*)(ws + WS_XB), (float*)(ws + WS_SSQ), 0.0f}; pg8::gemm_phase<pg8::EpiResid>(lds, g, so, E2); }
#endif
                }
                GSYNC();
            }
        }
    }
}

extern "C" void kernel_launch(void* const* d_in, const int* in_sizes, int n_in, void* d_out, int out_size, void* d_ws, size_t ws_size, hipStream_t stream) {
    static int grid = 0;
    if (grid == 0) {
        if (n_in != 23 || out_size != S * D || ws_size < WS_END) { fprintf(stderr, "kernel_launch: unexpected shapes (n_in %d out %d ws %zu need %zu)\n", n_in, out_size, ws_size, (size_t)WS_END); grid = -1; return; }
        int dev = 0, cus = 0, per_cu = 0;
        hipGetDevice(&dev);
        hipDeviceGetAttribute(&cus, hipDeviceAttributeMultiprocessorCount, dev);
        if (hipFuncSetAttribute((const void*)fwd_megakernel, hipFuncAttributeMaxDynamicSharedMemorySize, LDS_BYTES) != hipSuccess) { fprintf(stderr, "hipFuncSetAttribute failed\n"); grid = -1; return; }
        hipOccupancyMaxActiveBlocksPerMultiprocessor(&per_cu, (const void*)fwd_megakernel, 512, LDS_BYTES);
        (void)hipGetLastError();
        if (per_cu < 1) per_cu = 1;
        grid = cus;
        if (grid > 256) grid = 256;
    }
    if (grid < 0) return;
    if (hipMemsetAsync((char*)d_ws + WS_CTL, 0, CTL_BYTES, stream) != hipSuccess) { fprintf(stderr, "memset failed\n"); return; }
    Args a{};
    for (int i = 0; i < 23; ++i) a.in[i] = (const float*)d_in[i];
    a.out = (float*)d_out; a.ws = (unsigned char*)d_ws;
    void* args[] = {&a};
    hipError_t e = hipLaunchCooperativeKernel((const void*)fwd_megakernel, dim3(grid), dim3(512), args, LDS_BYTES, stream);
    if (e != hipSuccess) fprintf(stderr, "cooperative launch failed: %s (grid %d)\n", hipGetErrorString(e), grid);
}
```

```cpp
#include <hip/hip_runtime.h>
#include <hip/hip_cooperative_groups.h>
#include <cstdio>
#include <cstdint>
namespace cg = cooperative_groups;

#define LAS __attribute__((address_space(3)))
typedef unsigned short bf16_t;
typedef short bf16x8 __attribute__((ext_vector_type(8)));
typedef short s16x4 __attribute__((ext_vector_type(4)));
typedef float f32x4 __attribute__((ext_vector_type(4)));
typedef float f32x16 __attribute__((ext_vector_type(16)));
typedef unsigned u32x4 __attribute__((ext_vector_type(4)));
typedef unsigned u32x2 __attribute__((ext_vector_type(2)));

constexpr int S = 16384, D = 1024, FF = 2816, DEPTH = 4;
constexpr int ZW = 1280;
constexpr int NH = 8, DQK = 96, DV = 64;
constexpr float EPS = 1e-6f;

__device__ __forceinline__ unsigned cvt_pk_bf16(float lo, float hi) { unsigned r; asm volatile("v_cvt_pk_bf16_f32 %0, %1, %2" : "=v"(r) : "v"(lo), "v"(hi)); return r; }
__device__ __forceinline__ float bf_lo(unsigned w) { return __uint_as_float(w << 16); }
__device__ __forceinline__ float bf_hi(unsigned w) { return __uint_as_float(w & 0xffff0000u); }
__device__ __forceinline__ float bf_one(bf16_t v) { return __uint_as_float(((unsigned)v) << 16); }
__device__ __forceinline__ bf16_t f2bf(float f) { return (bf16_t)(cvt_pk_bf16(f, 0.f) & 0xffffu); }

constexpr int WTAB_OFF = 131072 + 64 + 2048;
__device__ __forceinline__ int lane_id() { int l = (int)__builtin_amdgcn_mbcnt_hi(~0u, __builtin_amdgcn_mbcnt_lo(~0u, 0u)); asm volatile("" : "+v"(l)); return l; }
__device__ __forceinline__ int shx(int v, int m) { return __builtin_amdgcn_ds_bpermute((lane_id() ^ m) << 2, v); }
__device__ __forceinline__ unsigned shx(unsigned v, int m) { return (unsigned)__builtin_amdgcn_ds_bpermute((lane_id() ^ m) << 2, (int)v); }
__device__ __forceinline__ float shx(float v, int m) { return __int_as_float(__builtin_amdgcn_ds_bpermute((lane_id() ^ m) << 2, __float_as_int(v))); }
__device__ __forceinline__ unsigned hw_slot() { return (unsigned)__builtin_amdgcn_s_getreg((5 << 11) | 4) & 0x3fu; }
__device__ __forceinline__ int wave_index(LAS unsigned char* lds) { return __builtin_amdgcn_readfirstlane(((volatile LAS int*)(lds + WTAB_OFF))[hw_slot()]); }
namespace pg8 {
constexpr int BM = 256, BK = 64, HALF = 128, HTB = HALF * BK * 2, STAGE_BYTES = 8 * HTB, NXCD = 8, WGM = 8;
__host__ __device__ __forceinline__ int lds_byte(int r, int c) { const int st = (r >> 4) * 2 + (c >> 5), rr = r & 15, cc = c & 31, ob = rr * 64 + cc * 2; return st * 1024 + (ob ^ (((ob >> 9) & 1) << 5)); }
__host__ __device__ __forceinline__ void stage_rc(int b, int& R, int& C) { const int st = b / 1024, sb = b % 1024, swz = sb ^ (((sb >> 9) & 1) << 5); R = (st >> 1) * 16 + swz / 64; C = (st & 1) * 32 + (swz % 64) / 2; }
__host__ __device__ __forceinline__ int perm32(int rho) { const int n = rho >> 4, i = rho & 15; return 8 * (i >> 2) + 4 * n + (i & 3); }

struct Unit { int pm, pn; };
struct Gemm { const bf16_t* A; const bf16_t* Bt; int M, N, K, lda, ldb; };

struct StaticOrder {
    int nM, nN, nwg, G, c;
    __device__ __forceinline__ void init(int M, int N, int G_, int c_) { nM = M / BM; nN = N / BM; nwg = nM * nN; G = G_; c = c_; asm volatile("" : "+s"(c)); }
    __device__ __forceinline__ bool next(int i, Unit& u) const {
        const long L = (long)i * G + c; if (L >= nwg) return false;
        int wgid = (int)L; { const int q = nwg / NXCD, r = nwg % NXCD, xcd = wgid % NXCD, off = wgid / NXCD; wgid = (xcd < r ? xcd * (q + 1) : r * (q + 1) + (xcd - r) * q) + off; }
        const int nig = WGM * nN, gid = wgid / nig, fm = gid * WGM, gsz = (nM - fm) < WGM ? (nM - fm) : WGM;
        u.pm = fm + ((wgid % nig) % gsz); u.pn = (wgid % nig) / gsz; return true;
    }
};

template <class Epi, bool ALIGN_EPI = true, bool SP2 = true>
__device__ __forceinline__ void gemm_phase(LAS unsigned char* lds, const Gemm g, const StaticOrder& S, const Epi& E) {
    const int wid = wave_index(lds); int tid_ = wid * 64 + lane_id(); asm volatile("" : "+v"(tid_));
    const int tid = tid_, lane = tid & 63, wr = wid >> 2, wc = wid & 3, fr = lane & 15, fq = lane >> 4;
    const int K = g.K, nt = K / BK;
    unsigned voffA[2], voffB[2];
#pragma unroll
    for (int i = 0; i < 2; ++i) { int R, C; stage_rc(tid * 16 + i * 8192, R, C); const int Rb = Epi::PERM ? ((R & ~31) + perm32(R & 31)) : R;
        voffA[i] = (unsigned)(R * g.lda + C) * 2u; voffB[i] = (unsigned)(Rb * g.ldb + C) * 2u; }
    const size_t kstep = (size_t)(BK * 2);
    const size_t hstepA = (size_t)HALF * g.lda * 2, hstepB = (size_t)HALF * g.ldb * 2;
    const size_t tstepA = 2 * hstepA, tstepB = 2 * hstepB;
    const unsigned ldsw = (unsigned)wid * 1024u;
    const int aoff = lds_byte(wr * 64 + fr, fq * 8), boff = lds_byte(wc * 32 + fr, fq * 8);
#define PG8_SA(b, h) (((b) * 2 + (h)) * HTB)
#define PG8_SB(b, h) ((4 + (b) * 2 + (h)) * HTB)
#define PG8_STAGE(bufoff, gbase, voff) do { _Pragma("unroll") for (int _i = 0; _i < 2; ++_i) \
        __builtin_amdgcn_global_load_lds((const unsigned*)((const char*)(gbase) + (voff)[_i]), (LAS unsigned*)(lds + (bufoff) + ldsw + _i * 8192), 16, 0, 0); } while (0)
#define PG8_LDA(dst, b, h) do { _Pragma("unroll") for (int m = 0; m < 4; ++m) _Pragma("unroll") for (int k = 0; k < 2; ++k) dst[m][k] = *(const LAS bf16x8*)(lds + PG8_SA(b, h) + aoff + m * 2048 + k * 1024); } while (0)
#define PG8_LDB(dst, b, h) do { _Pragma("unroll") for (int n = 0; n < 2; ++n) _Pragma("unroll") for (int k = 0; k < 2; ++k) dst[n][k] = *(const LAS bf16x8*)(lds + PG8_SB(b, h) + boff + n * 2048 + k * 1024); } while (0)
#define PG8_MMA(ai, bj, At, Bt) do { __builtin_amdgcn_s_setprio(1); _Pragma("unroll") for (int m = 0; m < 4; ++m) _Pragma("unroll") for (int n = 0; n < 2; ++n) _Pragma("unroll") for (int k = 0; k < 2; ++k) \
        acc[ai][bj][m][n] = __builtin_amdgcn_mfma_f32_16x16x32_bf16(Bt[n][k], At[m][k], acc[ai][bj][m][n], 0, 0, 0); __builtin_amdgcn_s_setprio(0); } while (0)
#define PG8_WAIT_V(n) asm volatile("s_waitcnt vmcnt(" #n ")" ::: "memory")
#define PG8_WAIT_L(n) asm volatile("s_waitcnt lgkmcnt(" #n ")" ::: "memory")
#define PG8_BAR __builtin_amdgcn_s_barrier()
#define PG8_SCHED __builtin_amdgcn_sched_barrier(0)
    Unit cur, nxt; int ui = 0;
    if (!S.next(0, cur)) return;
    f32x4 acc[2][2][4][2];
#pragma unroll
    for (int a = 0; a < 2; ++a)
#pragma unroll
        for (int b = 0; b < 2; ++b)
#pragma unroll
            for (int m = 0; m < 4; ++m)
#pragma unroll
                for (int n = 0; n < 2; ++n) acc[a][b][m][n] = (f32x4){0.f, 0.f, 0.f, 0.f};
    bf16x8 At[4][2], B0[2][2], B1[2][2];
    const char* cA = (const char*)g.A + (size_t)cur.pm * tstepA; const char* cB = (const char*)g.Bt + (size_t)cur.pn * tstepB;
    if constexpr (SP2) {
        PG8_STAGE(PG8_SB(0, 0), cB, voffB); PG8_STAGE(PG8_SB(0, 1), cB + hstepB, voffB); PG8_STAGE(PG8_SA(0, 0), cA, voffA); PG8_STAGE(PG8_SA(0, 1), cA + hstepA, voffA);
        if (wr == 1) PG8_BAR;
        PG8_WAIT_V(2); PG8_BAR;
        PG8_STAGE(PG8_SB(1, 0), cB + kstep, voffB); PG8_STAGE(PG8_SA(1, 0), cA + kstep, voffA); PG8_STAGE(PG8_SB(1, 1), cB + hstepB + kstep, voffB);
        PG8_WAIT_V(6); PG8_BAR;
    } else {
        PG8_STAGE(PG8_SB(0, 0), cB, voffB); PG8_STAGE(PG8_SA(0, 0), cA, voffA); PG8_STAGE(PG8_SB(0, 1), cB + hstepB, voffB); PG8_STAGE(PG8_SA(0, 1), cA + hstepA, voffA);
        if (wr == 1) PG8_BAR;
        PG8_WAIT_V(4); PG8_BAR;
        PG8_STAGE(PG8_SB(1, 0), cB + kstep, voffB); PG8_STAGE(PG8_SA(1, 0), cA + kstep, voffA); PG8_STAGE(PG8_SB(1, 1), cB + hstepB + kstep, voffB);
        PG8_WAIT_V(6); PG8_BAR;
    }
    for (;;) {
        const bool has_next = S.next(ui + 1, nxt);
        const char* nA = has_next ? (const char*)g.A + (size_t)nxt.pm * tstepA : cA; const char* nB = has_next ? (const char*)g.Bt + (size_t)nxt.pn * tstepB : cB;
        for (int t = 0; t < nt; t += 2) {
            const bool last = (t == nt - 2);
            const char* a1 = cA + (size_t)(t + 1) * kstep;
            const char* a2 = last ? nA : cA + (size_t)(t + 2) * kstep; const char* b2 = last ? nB : cB + (size_t)(t + 2) * kstep;
            const char* a3 = a2 + kstep; const char* b3 = b2 + kstep;
            if constexpr (SP2) {
            PG8_LDB(B0, 0, 0); PG8_LDB(B1, 0, 1); PG8_SCHED; PG8_LDA(At, 0, 0); PG8_STAGE(PG8_SA(1, 1), a1 + hstepA, voffA);
            PG8_WAIT_V(8); PG8_WAIT_L(0); PG8_BAR; PG8_MMA(0, 0, At, B0); PG8_MMA(0, 1, At, B1); PG8_BAR; PG8_SCHED;
            PG8_LDA(At, 0, 1); PG8_STAGE(PG8_SB(0, 0), b2, voffB); PG8_STAGE(PG8_SB(0, 1), b2 + hstepB, voffB); PG8_STAGE(PG8_SA(0, 0), a2, voffA);
            PG8_WAIT_V(8); PG8_WAIT_L(0); PG8_BAR; PG8_MMA(1, 0, At, B0); PG8_MMA(1, 1, At, B1); PG8_BAR; PG8_SCHED;
            PG8_LDB(B0, 1, 0); PG8_LDB(B1, 1, 1); PG8_SCHED; PG8_LDA(At, 1, 0); PG8_STAGE(PG8_SA(0, 1), a2 + hstepA, voffA);
            PG8_WAIT_V(8); PG8_WAIT_L(0); PG8_BAR; PG8_MMA(0, 0, At, B0); PG8_MMA(0, 1, At, B1); PG8_BAR; PG8_SCHED;
            PG8_LDA(At, 1, 1); PG8_STAGE(PG8_SB(1, 0), b3, voffB); PG8_STAGE(PG8_SB(1, 1), b3 + hstepB, voffB); PG8_STAGE(PG8_SA(1, 0), a3, voffA);
            PG8_WAIT_V(8); PG8_WAIT_L(0); PG8_BAR; PG8_MMA(1, 0, At, B0); PG8_MMA(1, 1, At, B1); PG8_BAR; PG8_SCHED;
            } else {
            PG8_LDB(B0, 0, 0); PG8_SCHED; PG8_LDA(At, 0, 0); PG8_STAGE(PG8_SA(1, 1), a1 + hstepA, voffA);
            PG8_WAIT_L(8); PG8_BAR; PG8_WAIT_L(0); PG8_MMA(0, 0, At, B0); PG8_BAR; PG8_SCHED;
            PG8_LDB(B1, 0, 1); PG8_STAGE(PG8_SB(0, 0), b2, voffB);
            PG8_BAR; PG8_WAIT_L(0); PG8_MMA(0, 1, At, B1); PG8_BAR;
            PG8_LDA(At, 0, 1); PG8_STAGE(PG8_SA(0, 0), a2, voffA);
            PG8_BAR; PG8_WAIT_L(0); PG8_MMA(1, 0, At, B0); PG8_BAR; PG8_SCHED;
            PG8_STAGE(PG8_SB(0, 1), b2 + hstepB, voffB);
            PG8_WAIT_V(6); PG8_BAR; PG8_MMA(1, 1, At, B1); PG8_BAR;
            PG8_LDB(B0, 1, 0); PG8_SCHED; PG8_LDA(At, 1, 0); PG8_STAGE(PG8_SA(0, 1), a2 + hstepA, voffA);
            PG8_WAIT_L(8); PG8_BAR; PG8_WAIT_L(0); PG8_MMA(0, 0, At, B0); PG8_BAR; PG8_SCHED;
            PG8_LDB(B1, 1, 1); PG8_STAGE(PG8_SB(1, 0), b3, voffB);
            PG8_BAR; PG8_WAIT_L(0); PG8_MMA(0, 1, At, B1); PG8_BAR;
            PG8_LDA(At, 1, 1); PG8_STAGE(PG8_SA(1, 0), a3, voffA);
            PG8_BAR; PG8_WAIT_L(0); PG8_MMA(1, 0, At, B0); PG8_BAR; PG8_SCHED;
            PG8_STAGE(PG8_SB(1, 1), b3 + hstepB, voffB);
            PG8_WAIT_V(6); PG8_BAR; PG8_MMA(1, 1, At, B1); PG8_BAR;
            }
        }
        if constexpr (ALIGN_EPI) { if (wr == 0) PG8_BAR; }
        E(acc, cur, has_next ? nxt.pm : cur.pm, ui, wr, wc, fr, fq);
        if (!has_next) break;
#pragma unroll
        for (int a = 0; a < 2; ++a)
#pragma unroll
            for (int b = 0; b < 2; ++b)
#pragma unroll
                for (int m = 0; m < 4; ++m)
#pragma unroll
                    for (int n = 0; n < 2; ++n) acc[a][b][m][n] = (f32x4){0.f, 0.f, 0.f, 0.f};
        cur = nxt; cA = nA; cB = nB; ++ui;
        if constexpr (ALIGN_EPI) { if (wr == 1) PG8_BAR; }
    }
    PG8_WAIT_V(0);
    if constexpr (!ALIGN_EPI) { if (wr == 0) PG8_BAR; }
    PG8_BAR;
#undef PG8_SA
#undef PG8_SB
#undef PG8_STAGE
#undef PG8_LDA
#undef PG8_LDB
#undef PG8_MMA
#undef PG8_WAIT_V
#undef PG8_WAIT_L
#undef PG8_BAR
#undef PG8_SCHED
}

__device__ __forceinline__ float rstd16(const float* ssq, int r) {
    const f32x4* p = (const f32x4*)(ssq + (size_t)r * 16);
    const f32x4 a = p[0], b = p[1], c = p[2], d = p[3];
    const float s = ((a[0] + a[1]) + (a[2] + a[3])) + ((b[0] + b[1]) + (b[2] + b[3])) + ((c[0] + c[1]) + (c[2] + c[3])) + ((d[0] + d[1]) + (d[2] + d[3]));
    return __builtin_amdgcn_rsqf(s * (1.0f / 1024.0f) + EPS);
}
constexpr int RSL_OFF = 131072 + 64;
template <int MODE> __device__ __forceinline__ const LAS float* tile_rstd_to_lds(LAS unsigned char* lds, int pm, int pm_next, int ui, const float* p, int sel, int tid) {
    LAS float* rsl = (LAS float*)(lds + RSL_OFF);
    if ((ui & 1) == 0) {
        const int half = tid >> 8, rr = tid & 255;
        const int row = (half ? pm_next : pm) * BM + rr;
        rsl[half * 256 + rr] = (MODE == 0) ? rstd16(p, row) : p[(size_t)row * 2 + sel];
        asm volatile("s_waitcnt lgkmcnt(0)" ::: "memory");
        __builtin_amdgcn_s_barrier();
        asm volatile("" ::: "memory");
    }
    return rsl + (ui & 1) * 256;
}
__device__ __forceinline__ float silu_f(float x) { return x * __builtin_amdgcn_rcpf(1.0f + __builtin_amdgcn_exp2f(-1.4426950408889634f * x)); }

struct EpiSwiGLU {
    static constexpr bool PERM = true;
    bf16_t* H; const float* ssq; LAS unsigned char* lds;
    __device__ __forceinline__ void operator()(const f32x4 (&acc)[2][2][4][2], const Unit& u, int pm_next, int ui, int wr, int wc, int fr, int fq) const {
        const int row0 = u.pm * BM + wr * 64 + fr, col0 = u.pn * 128 + wc * 32 + 8 * fq;
        const LAS float* rsl = tile_rstd_to_lds<0>(lds, u.pm, pm_next, ui, ssq, 0, (wr * 4 + wc) * 64 + fq * 16 + fr);
#pragma unroll
        for (int ai = 0; ai < 2; ++ai)
#pragma unroll
            for (int m = 0; m < 4; ++m) {
                const int r = row0 + ai * HALF + m * 16; const float rs = rsl[wr * 64 + fr + ai * HALF + m * 16];
                float hv[8];
#pragma unroll
                for (int n = 0; n < 2; ++n)
#pragma unroll
                    for (int j = 0; j < 4; ++j) hv[n * 4 + j] = silu_f(acc[ai][0][m][n][j] * rs) * (acc[ai][1][m][n][j] * rs);
                u32x4 w; w.x = cvt_pk_bf16(hv[0], hv[1]); w.y = cvt_pk_bf16(hv[2], hv[3]); w.z = cvt_pk_bf16(hv[4], hv[5]); w.w = cvt_pk_bf16(hv[6], hv[7]);
                *(u32x4*)(H + (size_t)r * FF + col0) = w;
            }
    }
};
struct EpiResid {
    static constexpr bool PERM = true;
    float* out; bf16_t* xb; float* ssq; float alpha;
    __device__ __forceinline__ void operator()(const f32x4 (&acc)[2][2][4][2], const Unit& u, int pm_next, int ui, int wr, int wc, int fr, int fq) const {
        const int row0 = u.pm * BM + wr * 64 + fr, col0 = u.pn * BM + wc * 32 + 8 * fq;
        u32x4 bwv[2][4][2];
#pragma unroll
        for (int ai = 0; ai < 2; ++ai)
#pragma unroll
            for (int m = 0; m < 4; ++m)
#pragma unroll
                for (int bj = 0; bj < 2; ++bj) bwv[ai][m][bj] = *(const u32x4*)(xb + (size_t)(row0 + ai * HALF + m * 16) * D + col0 + bj * HALF);
        asm volatile("" ::: "memory");
#pragma unroll
        for (int ai = 0; ai < 2; ++ai)
#pragma unroll
            for (int m = 0; m < 4; ++m) {
                const int r = row0 + ai * HALF + m * 16; const size_t off = (size_t)r * D + col0; float s = 0.f;
#pragma unroll
                for (int bj = 0; bj < 2; ++bj) {
                    const u32x4 bw = bwv[ai][m][bj];
                    const f32x4 a0 = acc[ai][bj][m][0], a1 = acc[ai][bj][m][1];
                    const float o0 = bf_lo(bw.x) + a0[0] * alpha, o1 = bf_hi(bw.x) + a0[1] * alpha, o2 = bf_lo(bw.y) + a0[2] * alpha, o3 = bf_hi(bw.y) + a0[3] * alpha;
                    const float o4 = bf_lo(bw.z) + a1[0] * alpha, o5 = bf_hi(bw.z) + a1[1] * alpha, o6 = bf_lo(bw.w) + a1[2] * alpha, o7 = bf_hi(bw.w) + a1[3] * alpha;
                    u32x4 w; w.x = cvt_pk_bf16(o0, o1); w.y = cvt_pk_bf16(o2, o3); w.z = cvt_pk_bf16(o4, o5); w.w = cvt_pk_bf16(o6, o7);
                    *(u32x4*)(xb + off + bj * HALF) = w;
                    if (out) { *(f32x4*)(out + off + bj * HALF) = (f32x4){o0, o1, o2, o3}; *(f32x4*)(out + off + bj * HALF + 4) = (f32x4){o4, o5, o6, o7}; }
                    const float q0 = bf_lo(w.x), q1 = bf_hi(w.x), q2 = bf_lo(w.y), q3 = bf_hi(w.y), q4 = bf_lo(w.z), q5 = bf_hi(w.z), q6 = bf_lo(w.w), q7 = bf_hi(w.w);
                    s += ((q0 * q0 + q1 * q1) + (q2 * q2 + q3 * q3)) + ((q4 * q4 + q5 * q5) + (q6 * q6 + q7 * q7));
                }
                s += shx(s, 16); s += shx(s, 32);
                if (fq == 0) ssq[(size_t)r * 16 + u.pn * 4 + wc] = s;
            }
    }
};
template <int MODE> struct EpiRowBf16 {
    static constexpr bool PERM = true;
    bf16_t* O; int ldc; const float* rsp; int sel; LAS unsigned char* lds;
    __device__ __forceinline__ void operator()(const f32x4 (&acc)[2][2][4][2], const Unit& u, int pm_next, int ui, int wr, int wc, int fr, int fq) const {
        const int row0 = u.pm * BM + wr * 64 + fr, col0 = u.pn * BM + wc * 32 + 8 * fq;
        const LAS float* rsl = tile_rstd_to_lds<MODE>(lds, u.pm, pm_next, ui, rsp, sel, (wr * 4 + wc) * 64 + fq * 16 + fr);
#pragma unroll
        for (int ai = 0; ai < 2; ++ai)
#pragma unroll
            for (int m = 0; m < 4; ++m) {
                const int r = row0 + ai * HALF + m * 16; const float rs = rsl[wr * 64 + fr + ai * HALF + m * 16];
#pragma unroll
                for (int bj = 0; bj < 2; ++bj) {
                    const f32x4 v0 = acc[ai][bj][m][0] * rs, v1 = acc[ai][bj][m][1] * rs;
                    u32x4 w; w.x = cvt_pk_bf16(v0[0], v0[1]); w.y = cvt_pk_bf16(v0[2], v0[3]); w.z = cvt_pk_bf16(v1[0], v1[1]); w.w = cvt_pk_bf16(v1[2], v1[3]);
                    *(u32x4*)(O + (size_t)r * ldc + col0 + bj * HALF) = w;
                }
            }
    }
};
struct EpiColBf16 {
    static constexpr bool PERM = true;
    bf16_t* O; int ldc; const float* rsd;
    __device__ __forceinline__ void operator()(const f32x4 (&acc)[2][2][4][2], const Unit& u, int pm_next, int ui, int wr, int wc, int fr, int fq) const {
        const int row0 = u.pm * BM + wr * 64 + fr, col0 = u.pn * BM + wc * 32 + 8 * fq;
        float cs[2][8];
#pragma unroll
        for (int bj = 0; bj < 2; ++bj)
#pragma unroll
            for (int j = 0; j < 8; ++j) cs[bj][j] = rsd[(size_t)(col0 + bj * HALF + j) * 2 + 1];
        asm volatile("" ::: "memory");
#pragma unroll
        for (int bj = 0; bj < 2; ++bj)
#pragma unroll
            for (int ai = 0; ai < 2; ++ai)
#pragma unroll
                for (int m = 0; m < 4; ++m) {
                    const int r = row0 + ai * HALF + m * 16;
                    const f32x4 v0 = acc[ai][bj][m][0], v1 = acc[ai][bj][m][1];
                    u32x4 w; w.x = cvt_pk_bf16(v0[0] * cs[bj][0], v0[1] * cs[bj][1]); w.y = cvt_pk_bf16(v0[2] * cs[bj][2], v0[3] * cs[bj][3]);
                    w.z = cvt_pk_bf16(v1[0] * cs[bj][4], v1[1] * cs[bj][5]); w.w = cvt_pk_bf16(v1[2] * cs[bj][6], v1[3] * cs[bj][7]);
                    *(u32x4*)(O + (size_t)r * ldc + col0 + bj * HALF) = w;
                }
    }
};
struct EpiConvIn {
    static constexpr bool PERM = true;
    bf16_t* U; bf16_t* GB; const float* ssq; LAS unsigned char* lds;
    __device__ __forceinline__ void operator()(const f32x4 (&acc)[2][2][4][2], const Unit& u, int pm_next, int ui, int wr, int wc, int fr, int fq) const {
        const int row0 = u.pm * BM + wr * 64 + fr;
        const LAS float* rsl = tile_rstd_to_lds<0>(lds, u.pm, pm_next, ui, ssq, 0, (wr * 4 + wc) * 64 + fq * 16 + fr);
#pragma unroll
        for (int ai = 0; ai < 2; ++ai)
#pragma unroll
            for (int m = 0; m < 4; ++m) {
                const int r = row0 + ai * HALF + m * 16; const float rs = rsl[wr * 64 + fr + ai * HALF + m * 16];
                if (u.pn < 8) {
                    const f32x4 v0 = (acc[ai][0][m][0] * rs) * (acc[ai][1][m][0] * rs), v1 = (acc[ai][0][m][1] * rs) * (acc[ai][1][m][1] * rs);
                    u32x4 w; w.x = cvt_pk_bf16(v0[0], v0[1]); w.y = cvt_pk_bf16(v0[2], v0[3]); w.z = cvt_pk_bf16(v1[0], v1[1]); w.w = cvt_pk_bf16(v1[2], v1[3]);
                    *(u32x4*)(U + (size_t)r * D + u.pn * 128 + wc * 32 + 8 * fq) = w;
                } else {
#pragma unroll
                    for (int bj = 0; bj < 2; ++bj) {
                        const f32x4 v0 = acc[ai][bj][m][0] * rs, v1 = acc[ai][bj][m][1] * rs;
                        u32x4 w; w.x = cvt_pk_bf16(v0[0], v0[1]); w.y = cvt_pk_bf16(v0[2], v0[3]); w.z = cvt_pk_bf16(v1[0], v1[1]); w.w = cvt_pk_bf16(v1[2], v1[3]);
                        *(u32x4*)(GB + (size_t)r * D + (u.pn - 8) * BM + bj * HALF + wc * 32 + 8 * fq) = w;
                    }
                }
            }
    }
};
}

namespace att {
constexpr int KROW = 208, VROW = 144, KBUF = 64 * KROW, VBUF = 64 * VROW;
constexpr int LDS_K0 = 0, LDS_V0 = 3 * KBUF, LDS_SC = LDS_V0 + 2 * VBUF, LDS_TOTAL = LDS_SC + 8 * 32 * 4;
__device__ __forceinline__ int crow(int r, int hi) { return (r & 3) + 8 * (r >> 2) + 4 * hi; }

__device__ __forceinline__ void attn_qk(f32x16& P0, f32x16& P1, const LAS unsigned char* kb, const bf16x8 (&qr)[6]) {
    f32x16 z;
#pragma unroll
    for (int r = 0; r < 16; ++r) z[r] = 0.f;
    bf16x8 kf[12];
#pragma unroll
    for (int d0 = 0; d0 < 6; ++d0) { kf[2 * d0] = *(const LAS bf16x8*)(kb + d0 * 32); kf[2 * d0 + 1] = *(const LAS bf16x8*)(kb + 32 * KROW + d0 * 32); }
    __builtin_amdgcn_sched_barrier(0);
#pragma unroll
    for (int d0 = 0; d0 < 6; ++d0) {
        if (d0 == 0) { P0 = __builtin_amdgcn_mfma_f32_32x32x16_bf16(kf[0], qr[0], z, 0, 0, 0); P1 = __builtin_amdgcn_mfma_f32_32x32x16_bf16(kf[1], qr[0], z, 0, 0, 0); }
        else { P0 = __builtin_amdgcn_mfma_f32_32x32x16_bf16(kf[2 * d0], qr[d0], P0, 0, 0, 0); P1 = __builtin_amdgcn_mfma_f32_32x32x16_bf16(kf[2 * d0 + 1], qr[d0], P1, 0, 0, 0); }
    }
    __builtin_amdgcn_sched_barrier(0);
}
__device__ __forceinline__ void attn_sm_pv(f32x16& P0, f32x16& P1, f32x16& o0, f32x16& o1, float& l_run, const LAS unsigned char* vb, bool diag, int q, int kvb) {
    if (diag) {
#pragma unroll
        for (int r = 0; r < 16; ++r) { const int kv = kvb + (r & 3) + 8 * (r >> 2); if (kv > q) P0[r] = -INFINITY; if (kv + 32 > q) P1[r] = -INFINITY; }
    }
    bf16x8 vfr[8];
#pragma unroll
    for (int s = 0; s < 4; ++s) { vfr[2 * s] = *(const LAS bf16x8*)(vb + s * 32); vfr[2 * s + 1] = *(const LAS bf16x8*)(vb + 32 * VROW + s * 32); }
    __builtin_amdgcn_sched_barrier(0);
    float s0 = 0.f, s1 = 0.f;
#pragma unroll
    for (int r = 0; r < 16; ++r) { P0[r] = __builtin_amdgcn_exp2f(P0[r]); P1[r] = __builtin_amdgcn_exp2f(P1[r]); s0 += P0[r]; s1 += P1[r]; }
    l_run += s0 + s1;
#pragma unroll
    for (int s = 0; s < 4; ++s) {
        u32x4 pw;
        if (s < 2) { const int b = 8 * s; pw.x = cvt_pk_bf16(P0[b], P0[b + 1]); pw.y = cvt_pk_bf16(P0[b + 2], P0[b + 3]); pw.z = cvt_pk_bf16(P0[b + 4], P0[b + 5]); pw.w = cvt_pk_bf16(P0[b + 6], P0[b + 7]); }
        else { const int b = 8 * (s - 2); pw.x = cvt_pk_bf16(P1[b], P1[b + 1]); pw.y = cvt_pk_bf16(P1[b + 2], P1[b + 3]); pw.z = cvt_pk_bf16(P1[b + 4], P1[b + 5]); pw.w = cvt_pk_bf16(P1[b + 6], P1[b + 7]); }
        const bf16x8 pa = __builtin_bit_cast(bf16x8, pw);
        o0 = __builtin_amdgcn_mfma_f32_32x32x16_bf16(pa, vfr[2 * s], o0, 0, 0, 0);
        o1 = __builtin_amdgcn_mfma_f32_32x32x16_bf16(pa, vfr[2 * s + 1], o1, 0, 0, 0);
    }
}

__device__ __forceinline__ void attn_qk_f(f32x16& P0, f32x16& P1, const LAS unsigned char* kb, const bf16x8 (&qr)[6]) {
    bf16x8 kf[12];
#pragma unroll
    for (int d0 = 0; d0 < 6; ++d0) { kf[2 * d0] = *(const LAS bf16x8*)(kb + d0 * 32); kf[2 * d0 + 1] = *(const LAS bf16x8*)(kb + 32 * KROW + d0 * 32); }
    __builtin_amdgcn_sched_barrier(0);
    f32x16 z;
#pragma unroll
    for (int r = 0; r < 16; ++r) z[r] = 0.f;
    __builtin_amdgcn_s_setprio(1);
    P0 = __builtin_amdgcn_mfma_f32_32x32x16_bf16(kf[0], qr[0], z, 0, 0, 0); P1 = __builtin_amdgcn_mfma_f32_32x32x16_bf16(kf[1], qr[0], z, 0, 0, 0);
#pragma unroll
    for (int d0 = 1; d0 < 6; ++d0) { P0 = __builtin_amdgcn_mfma_f32_32x32x16_bf16(kf[2 * d0], qr[d0], P0, 0, 0, 0); P1 = __builtin_amdgcn_mfma_f32_32x32x16_bf16(kf[2 * d0 + 1], qr[d0], P1, 0, 0, 0); }
    __builtin_amdgcn_s_setprio(0);
    __builtin_amdgcn_sched_barrier(0);
}
__device__ __forceinline__ void attn_sm_f(f32x16& P0, f32x16& P1, float& l_run, u32x4 (&pw)[4]) {
    float s0 = 0.f, s1 = 0.f;
#pragma unroll
    for (int r = 0; r < 16; ++r) { P0[r] = __builtin_amdgcn_exp2f(P0[r]); P1[r] = __builtin_amdgcn_exp2f(P1[r]); s0 += P0[r]; s1 += P1[r]; }
    l_run += s0 + s1;
#pragma unroll
    for (int s = 0; s < 2; ++s) { const int b = 8 * s;
        pw[s].x = cvt_pk_bf16(P0[b], P0[b + 1]); pw[s].y = cvt_pk_bf16(P0[b + 2], P0[b + 3]); pw[s].z = cvt_pk_bf16(P0[b + 4], P0[b + 5]); pw[s].w = cvt_pk_bf16(P0[b + 6], P0[b + 7]);
        pw[s + 2].x = cvt_pk_bf16(P1[b], P1[b + 1]); pw[s + 2].y = cvt_pk_bf16(P1[b + 2], P1[b + 3]); pw[s + 2].z = cvt_pk_bf16(P1[b + 4], P1[b + 5]); pw[s + 2].w = cvt_pk_bf16(P1[b + 6], P1[b + 7]); }
}
__device__ __forceinline__ void attn_pv_f(const u32x4 (&pw)[4], f32x16& o0, f32x16& o1, const LAS unsigned char* vb) {
    u32x2 va[4][2], vc[4][2];
#pragma unroll
    for (int s = 0; s < 4; ++s) { va[s][0] = *(const LAS u32x2*)(vb + s * 32); va[s][1] = *(const LAS u32x2*)(vb + s * 32 + 16);
        vc[s][0] = *(const LAS u32x2*)(vb + 32 * VROW + s * 32); vc[s][1] = *(const LAS u32x2*)(vb + 32 * VROW + s * 32 + 16); }
    __builtin_amdgcn_sched_barrier(0);
    __builtin_amdgcn_s_setprio(1);
#pragma unroll
    for (int s = 0; s < 4; ++s) {
        const bf16x8 pa = __builtin_bit_cast(bf16x8, pw[s]);
        o0 = __builtin_amdgcn_mfma_f32_32x32x16_bf16(pa, __builtin_bit_cast(bf16x8, (u32x4){va[s][0].x, va[s][0].y, va[s][1].x, va[s][1].y}), o0, 0, 0, 0);
        o1 = __builtin_amdgcn_mfma_f32_32x32x16_bf16(pa, __builtin_bit_cast(bf16x8, (u32x4){vc[s][0].x, vc[s][0].y, vc[s][1].x, vc[s][1].y}), o1, 0, 0, 0);
    }
    __builtin_amdgcn_s_setprio(0);
    __builtin_amdgcn_sched_barrier(0);
}

typedef float f32x2_t __attribute__((ext_vector_type(2))); typedef __bf16 bf16x2_t __attribute__((ext_vector_type(2)));
__device__ __forceinline__ unsigned cvtpk_s(float lo, float hi) { f32x2_t v = {lo, hi}; bf16x2_t b = __builtin_convertvector(v, bf16x2_t); return __builtin_bit_cast(unsigned, b); }
struct Stage3 { u32x4 k0, k1, v; };
template <int VAR> __device__ __forceinline__ Stage3 attn_full_step(f32x16& PA0, f32x16& PA1, f32x16& PB0, f32x16& PB1, f32x16& o0, f32x16& o1, float& l_run,
                                               const LAS unsigned char* kb, const LAS unsigned char* vb, const bf16x8 (&qr)[6],
                                               u32x4 kg0, u32x4 kg1, u32x4 vg, LAS unsigned char* kst0, LAS unsigned char* kst1, LAS unsigned char* vst, bool k1v,
                                               const char* kn0, const char* kn1, const bf16_t* vn) {
    bf16x8 kf[12], vf[8];
#pragma unroll
    for (int d0 = 0; d0 < 6; ++d0) { kf[2 * d0] = *(const LAS bf16x8*)(kb + d0 * 32); kf[2 * d0 + 1] = *(const LAS bf16x8*)(kb + 32 * KROW + d0 * 32); }
    __builtin_amdgcn_sched_barrier(0);
    f32x16 z;
#pragma unroll
    for (int r = 0; r < 16; ++r) z[r] = 0.f;
    __builtin_amdgcn_s_setprio(1);
    PB0 = __builtin_amdgcn_mfma_f32_32x32x16_bf16(kf[0], qr[0], z, 0, 0, 0); PB1 = __builtin_amdgcn_mfma_f32_32x32x16_bf16(kf[1], qr[0], z, 0, 0, 0);
#pragma unroll
    for (int d0 = 1; d0 < 6; ++d0) { PB0 = __builtin_amdgcn_mfma_f32_32x32x16_bf16(kf[2 * d0], qr[d0], PB0, 0, 0, 0); PB1 = __builtin_amdgcn_mfma_f32_32x32x16_bf16(kf[2 * d0 + 1], qr[d0], PB1, 0, 0, 0); }
    __builtin_amdgcn_s_setprio(0);
    __builtin_amdgcn_sched_barrier(0);
    if constexpr (!(VAR & 2)) {
        *(LAS u32x4*)kst0 = kg0; if (k1v) *(LAS u32x4*)kst1 = kg1;
        *(LAS u32x2*)vst = (u32x2){vg.x, vg.y}; *(LAS u32x2*)(vst + 16) = (u32x2){vg.z, vg.w};
        kg0 = *(const u32x4*)kn0; if (k1v) kg1 = *(const u32x4*)kn1;
        vg = *(const u32x4*)vn;
    }
#pragma unroll
    for (int s = 0; s < 4; ++s) { vf[2 * s] = *(const LAS bf16x8*)(vb + s * 32); vf[2 * s + 1] = *(const LAS bf16x8*)(vb + 32 * VROW + s * 32); }
    __builtin_amdgcn_sched_barrier(0);
    float s0 = 0.f, s1 = 0.f;
#pragma unroll
    for (int r = 0; r < 16; ++r) { PA0[r] = __builtin_amdgcn_exp2f(PA0[r]); PA1[r] = __builtin_amdgcn_exp2f(PA1[r]); s0 += PA0[r]; s1 += PA1[r]; }
    l_run += s0 + s1;
    u32x4 pw[4];
#pragma unroll
    for (int s = 0; s < 2; ++s) { const int b = 8 * s;
        pw[s].x = cvtpk_s(PA0[b], PA0[b + 1]); pw[s].y = cvtpk_s(PA0[b + 2], PA0[b + 3]); pw[s].z = cvtpk_s(PA0[b + 4], PA0[b + 5]); pw[s].w = cvtpk_s(PA0[b + 6], PA0[b + 7]);
        pw[s + 2].x = cvtpk_s(PA1[b], PA1[b + 1]); pw[s + 2].y = cvtpk_s(PA1[b + 2], PA1[b + 3]); pw[s + 2].z = cvtpk_s(PA1[b + 4], PA1[b + 5]); pw[s + 2].w = cvtpk_s(PA1[b + 6], PA1[b + 7]); }
    __builtin_amdgcn_sched_barrier(0);
    __builtin_amdgcn_s_setprio(1);
#pragma unroll
    for (int s = 0; s < 4; ++s) {
        const bf16x8 pa = __builtin_bit_cast(bf16x8, pw[s]);
        o0 = __builtin_amdgcn_mfma_f32_32x32x16_bf16(pa, vf[2 * s], o0, 0, 0, 0);
        o1 = __builtin_amdgcn_mfma_f32_32x32x16_bf16(pa, vf[2 * s + 1], o1, 0, 0, 0);
    }
    __builtin_amdgcn_s_setprio(0);
    __builtin_amdgcn_sched_barrier(0);
    Stage3 r_; r_.k0 = kg0; r_.k1 = kg1; r_.v = vg; return r_;
}

template <int VAR> __device__ __forceinline__ void attn_unit(int h, int qb, const bf16_t* Q, const bf16_t* K, const bf16_t* Vt, bf16_t* AO, LAS unsigned char* lds) {
    const int wid = wave_index(lds); int tid_ = wid * 64 + lane_id(); asm volatile("" : "+v"(tid_));
    const int tid = tid_, lane = tid & 63, r32 = lane & 31, hi = lane >> 5;
    const int q0w = qb * 256 + wid * 32, NT = 4 * qb + 4;
    const int tlast = (q0w + 31) >> 6;
    const char* Kh = (const char*)(K + (size_t)h * S * DQK);
    const bf16_t* Vh = Vt + (size_t)h * DV * S;
    bf16x8 qr[6];
    { const bf16_t* qp = Q + ((size_t)h * S + q0w + r32) * DQK + hi * 8;
#pragma unroll
      for (int d0 = 0; d0 < 6; ++d0) qr[d0] = *(const bf16x8*)(qp + d0 * 16); }
    const int c0 = tid, c1 = tid + 512;
    const int k0dst = (c0 / 12) * KROW + (c0 % 12) * 16, k1dst = (c1 / 12) * KROW + (c1 % 12) * 16;
    const int vrow = tid >> 3, vc8 = tid & 7, vdst = vrow * VROW + (vc8 >> 1) * 32 + (vc8 & 1) * 8;
    const bf16_t* vsrc = Vh + (size_t)vrow * S + vc8 * 8;
    const bool k1v = tid < 256;
    LAS float* sc = (LAS float*)(lds + LDS_SC) + wid * 32;
    const LAS unsigned char* kfrag = lds + LDS_K0 + r32 * KROW + hi * 16;
    const LAS unsigned char* vfrag = lds + LDS_V0 + r32 * VROW + hi * 16;
    const int q = q0w + r32;
    float l_run = 0.f;
    f32x16 o0, o1, pA0, pA1, pB0, pB1;
#pragma unroll
    for (int r = 0; r < 16; ++r) { o0[r] = 0.f; o1[r] = 0.f; pA0[r] = 0.f; pA1[r] = 0.f; pB0[r] = 0.f; pB1[r] = 0.f; }
#define ATT_KST(slot, g0, g1) do { *(LAS u32x4*)(lds + LDS_K0 + (slot) * KBUF + k0dst) = (g0); if (k1v) *(LAS u32x4*)(lds + LDS_K0 + (slot) * KBUF + k1dst) = (g1); } while (0)
#define ATT_VST(slot, g) do { *(LAS u32x2*)(lds + LDS_V0 + (slot) * VBUF + vdst) = (u32x2){(g).x, (g).y}; *(LAS u32x2*)(lds + LDS_V0 + (slot) * VBUF + vdst + 16) = (u32x2){(g).z, (g).w}; } while (0)
    u32x4 kg0, kg1 = (u32x4){0u, 0u, 0u, 0u}, vg;
    {
        const u32x4 z4 = (u32x4){0u, 0u, 0u, 0u};
        const u32x4 a = *(const u32x4*)(Kh + c0 * 16); const u32x4 b = k1v ? *(const u32x4*)(Kh + c1 * 16) : z4;
        const u32x4 a2 = *(const u32x4*)(Kh + 64 * DQK * 2 + c0 * 16); const u32x4 b2 = k1v ? *(const u32x4*)(Kh + 64 * DQK * 2 + c1 * 16) : z4;
        const u32x4 v = *(const u32x4*)(vsrc);
        kg0 = *(const u32x4*)(Kh + 2 * 64 * DQK * 2 + c0 * 16); if (k1v) kg1 = *(const u32x4*)(Kh + 2 * 64 * DQK * 2 + c1 * 16);
        vg = *(const u32x4*)(vsrc + 64);
        ATT_KST(0, a, b); ATT_KST(1, a2, b2); ATT_VST(0, v);
    }
    __syncthreads();
    attn_qk(pA0, pA1, kfrag, qr);
    int k1 = 1, k2 = 2;
#define ATT_STEP(PA0, PA1, PB0, PB1, t) do { \
        if ((t) + 2 < NT) ATT_KST(k2, kg0, kg1); \
        if ((t) + 1 < NT) ATT_VST(((t) + 1) & 1, vg); \
        if ((t) + 3 < NT) { const char* kt = Kh + (size_t)((t) + 3) * 64 * DQK * 2; kg0 = *(const u32x4*)(kt + c0 * 16); if (k1v) kg1 = *(const u32x4*)(kt + c1 * 16); } \
        if ((t) + 2 < NT) vg = *(const u32x4*)(vsrc + (size_t)((t) + 2) * 64); \
        if ((t) + 1 <= tlast) attn_qk(PB0, PB1, kfrag + k1 * KBUF, qr); \
        if ((t) <= tlast) attn_sm_pv(PA0, PA1, o0, o1, l_run, vfrag + ((t) & 1) * VBUF, 64 * (t) + 63 > q0w, q, 64 * (t) + 4 * hi); \
        __syncthreads(); \
        k1 = k2; k2 = (k2 == 2) ? 0 : k2 + 1; \
    } while (0)
#define ATT_FULL(PA0, PA1, PB0, PB1, t) do { \
        bf16x8 vf[8]; u32x4 pw[4]; f32x16 z_; \
        _Pragma("unroll") for (int r = 0; r < 16; ++r) z_[r] = 0.f; \
        float s0_ = 0.f, s1_ = 0.f; \
        _Pragma("unroll") for (int g = 0; g < 12; ++g) {        \
            if (g & 1) PB1 = __builtin_amdgcn_mfma_f32_32x32x16_bf16(kf[g], qr[g >> 1], (g == 1) ? z_ : PB1, 0, 0, 0); \
            else       PB0 = __builtin_amdgcn_mfma_f32_32x32x16_bf16(kf[g], qr[g >> 1], (g == 0) ? z_ : PB0, 0, 0, 0); \
            _Pragma("unroll") for (int e = (32 * g) / 12; e < (32 * (g + 1)) / 12; ++e) { \
                if (e < 16) { PA0[e] = __builtin_amdgcn_exp2f(PA0[e]); s0_ += PA0[e]; } else { PA1[e - 16] = __builtin_amdgcn_exp2f(PA1[e - 16]); s1_ += PA1[e - 16]; } } \
            __builtin_amdgcn_sched_barrier(0); \
        } \
        ATT_KST(k2, kg0, kg1); ATT_VST(((t) + 1) & 1, vg); \
        { const char* kt_ = Kh + (size_t)((t) + 3) * 64 * DQK * 2; kg0 = *(const u32x4*)(kt_ + c0 * 16); if (k1v) kg1 = *(const u32x4*)(kt_ + c1 * 16); } \
        vg = *(const u32x4*)(vsrc + (size_t)((t) + 2) * 64); \
        { const LAS unsigned char* vb_ = vfrag + ((t) & 1) * VBUF; \
          _Pragma("unroll") for (int s = 0; s < 4; ++s) { vf[2 * s] = *(const LAS bf16x8*)(vb_ + s * 32); vf[2 * s + 1] = *(const LAS bf16x8*)(vb_ + 32 * VROW + s * 32); } } \
        __builtin_amdgcn_sched_barrier(0); \
        l_run += s0_ + s1_; \
        _Pragma("unroll") for (int s = 0; s < 2; ++s) { const int b = 8 * s; \
            pw[s].x = cvtpk_s(PA0[b], PA0[b + 1]); pw[s].y = cvtpk_s(PA0[b + 2], PA0[b + 3]); pw[s].z = cvtpk_s(PA0[b + 4], PA0[b + 5]); pw[s].w = cvtpk_s(PA0[b + 6], PA0[b + 7]); \
            pw[s + 2].x = cvtpk_s(PA1[b], PA1[b + 1]); pw[s + 2].y = cvtpk_s(PA1[b + 2], PA1[b + 3]); pw[s + 2].z = cvtpk_s(PA1[b + 4], PA1[b + 5]); pw[s + 2].w = cvtpk_s(PA1[b + 6], PA1[b + 7]); } \
        __builtin_amdgcn_sched_barrier(0); \
        __syncthreads(); \
        __builtin_amdgcn_sched_barrier(0); \
        __builtin_amdgcn_s_setprio(1); \
        _Pragma("unroll") for (int s = 0; s < 4; ++s) { const bf16x8 pa_ = __builtin_bit_cast(bf16x8, pw[s]); \
            o0 = __builtin_amdgcn_mfma_f32_32x32x16_bf16(pa_, vf[2 * s], o0, 0, 0, 0); o1 = __builtin_amdgcn_mfma_f32_32x32x16_bf16(pa_, vf[2 * s + 1], o1, 0, 0, 0); } \
        __builtin_amdgcn_s_setprio(0); \
        { const LAS unsigned char* kb_ = kfrag + k2 * KBUF; \
          _Pragma("unroll") for (int d0 = 0; d0 < 6; ++d0) { kf[2 * d0] = *(const LAS bf16x8*)(kb_ + d0 * 32); kf[2 * d0 + 1] = *(const LAS bf16x8*)(kb_ + 32 * KROW + d0 * 32); } } \
        __builtin_amdgcn_sched_barrier(0); \
        k1 = k2; k2 = (k2 == 2) ? 0 : k2 + 1; \
    } while (0)
    int t = 0;
    bf16x8 kf[12];
    if (qb > 0) {
#pragma unroll
        for (int d0 = 0; d0 < 6; ++d0) { kf[2 * d0] = *(const LAS bf16x8*)(kfrag + KBUF + d0 * 32); kf[2 * d0 + 1] = *(const LAS bf16x8*)(kfrag + KBUF + 32 * KROW + d0 * 32); }
    }
    for (; t < 4 * qb; t += 2) {
        ATT_FULL(pA0, pA1, pB0, pB1, t);
        ATT_FULL(pB0, pB1, pA0, pA1, t + 1);
    }
    for (; t < NT; t += 2) {
        ATT_STEP(pA0, pA1, pB0, pB1, t);
        ATT_STEP(pB0, pB1, pA0, pA1, t + 1);
    }
#undef ATT_FULL
#undef ATT_STEP
#undef ATT_KST
#undef ATT_VST
    l_run += shx(l_run, 32);
    if (hi == 0) sc[r32] = __builtin_amdgcn_rcpf(l_run);
    bf16_t* ob = AO + (size_t)q0w * D + 512 + h * DV + r32;
#pragma unroll
    for (int gq = 0; gq < 4; ++gq) { const f32x4 av = *(const LAS f32x4*)(sc + 8 * gq + 4 * hi);
#pragma unroll
        for (int j = 0; j < 4; ++j) { const int r = 4 * gq + j; const int qrow = crow(r, hi);
            ob[(size_t)qrow * D] = f2bf(o0[r] * av[j]); ob[(size_t)qrow * D + 32] = f2bf(o1[r] * av[j]); } }
    __syncthreads();
}
}

constexpr size_t MiB = 1u << 20;
constexpr size_t WS_SSQ = 0;
constexpr size_t WS_RS = 1 * MiB;
constexpr size_t WS_CTL = 1 * MiB + 512 * 1024, CTL_BYTES = 16384;
constexpr int MISC_OFF = 131072 + 32;
constexpr size_t WS_W = 2 * MiB;
constexpr size_t W_FFN_LAYER = 33 * MiB;
constexpr size_t W_GU_BYTES = 11 * MiB, W_DN_BYTES = (size_t)D * FF * 2;
constexpr size_t WS_WEVEN = WS_W + 4 * W_FFN_LAYER;
constexpr size_t WE_IN = 0, WE_Q = (size_t)ZW * D * 2, WE_K = WE_Q + (size_t)768 * 384 * 2, WE_V = WE_K + (size_t)512 * 256 * 2, WE_OUT = WE_V + (size_t)512 * 256 * 2, WE_STRIDE = 6 * MiB;
static_assert(WE_OUT + (size_t)D * D * 2 <= WE_STRIDE, "even-layer weight map");
constexpr size_t WS_WODD = WS_WEVEN + 2 * WE_STRIDE;
constexpr size_t WO_IN = 0, WO_OUT = 6 * MiB, WO_STRIDE = 8 * MiB;
constexpr size_t WS_XB = WS_WODD + 2 * WO_STRIDE;
constexpr size_t WS_ACT = WS_XB + 32 * MiB;
constexpr size_t WS_H = WS_ACT;
constexpr size_t WS_Z = WS_ACT;
constexpr size_t WS_QP = WS_Z + 40 * MiB;
constexpr size_t WS_KP = WS_QP + 24 * MiB;
constexpr size_t WS_VT = WS_KP + 16 * MiB;
constexpr size_t WS_K = WS_VT + 16 * MiB;
constexpr size_t WS_AO = WS_K + 24 * MiB;
constexpr size_t WS_U = WS_ACT, WS_GB = WS_ACT + 32 * MiB;
constexpr size_t WS_Q = WS_AO + 32 * MiB;
constexpr size_t WS_END = WS_Q + 24 * MiB;

constexpr int LDS_BYTES = 131072 + 4096;

struct Args {
    const float* in[23]; float* out; unsigned char* ws;
};


#define XB_TMO      128
#define XB_XCNT(j)  (256  + 64 * (j))
#define XB_XSUB(j)  (1280 + 64 * (j))
#define XB_XGEN(j)  (2304 + 64 * (j))
#define XB_TOP      3328
#define XB_TOPGEN   3392
#define XCD_BAR_WORDS 3456
#define XB_SPIN_CAP (1u << 20)
__device__ __forceinline__ unsigned xb_ld(unsigned* p)              { return __hip_atomic_load(p, __ATOMIC_RELAXED, __HIP_MEMORY_SCOPE_AGENT); }
__device__ __forceinline__ unsigned xb_add(unsigned* p, unsigned v) { return __hip_atomic_fetch_add(p, v, __ATOMIC_RELAXED, __HIP_MEMORY_SCOPE_AGENT); }
__device__ __forceinline__ unsigned xb_xcc_id() { return (unsigned)__builtin_amdgcn_s_getreg((3 << 11) | 20) & 0xFu; }
#define XB_SPIN(cond, bar) do { unsigned _sp = 0; while (cond) { __builtin_amdgcn_s_sleep(1); \
    if ((++_sp & 255u) == 0u) { if (xb_ld(&(bar)[XB_TMO])) break; if (_sp > XB_SPIN_CAP) { atomicAdd(&(bar)[XB_TMO], 1u); break; } } } } while (0)
struct XcdBarrier { unsigned* bar; unsigned x; volatile LAS unsigned* st; };
__device__ __forceinline__ XcdBarrier xcd_barrier_post(unsigned* bar, volatile LAS unsigned* st, bool t0) {
    XcdBarrier b; b.bar = bar; b.x = xb_xcc_id(); b.st = st;
    if (t0) (void)xb_add(&bar[XB_XCNT(b.x)], 1u);
    return b;
}
__device__ __forceinline__ void xcd_barrier_complete(unsigned* bar, unsigned x, unsigned& nloc, unsigned& nx) {
    const unsigned G = gridDim.x * gridDim.y * gridDim.z;
    unsigned sum, cnt, mine, sp = 0u;
    for (;;) {
        sum = 0u; cnt = 0u; mine = 0u;
#pragma unroll
        for (unsigned j = 0; j < 16; ++j) { const unsigned c = xb_ld(&bar[XB_XCNT(j)]); sum += c; cnt += (c > 0u) ? 1u : 0u; mine = (j == x) ? c : mine; }
        if (sum == G) break;
        __builtin_amdgcn_s_sleep(1);
        if ((++sp & 255u) == 0u) { if (xb_ld(&bar[XB_TMO])) break; if (sp > XB_SPIN_CAP) { atomicAdd(&bar[XB_TMO], 1u); break; } }
    }
    nloc = mine > 0u ? mine : 1u; nx = cnt > 0u ? cnt : 1u;
}
__device__ __forceinline__ void xcd_barrier(const XcdBarrier& b, bool t0) {
    asm volatile("s_waitcnt vmcnt(0)" ::: "memory");
    __syncthreads();
    if (t0) {
        unsigned* bar = b.bar;
        __builtin_amdgcn_s_waitcnt(0);
        unsigned nloc = b.st[0], nx = b.st[1];
        if (nloc == 0u) { xcd_barrier_complete(bar, b.x, nloc, nx); b.st[0] = nloc; b.st[1] = nx; }
        const unsigned old = xb_add(&bar[XB_XSUB(b.x)], 1u);
        const unsigned gen = old / nloc;
        if (old + 1u == (gen + 1u) * nloc) {
            __builtin_amdgcn_fence(__ATOMIC_RELEASE, "agent");
            asm volatile("s_waitcnt vmcnt(0)" ::: "memory");
            const unsigned og = xb_add(&bar[XB_TOP], 1u);
            const unsigned tg = og / nx;
            if (og + 1u == (tg + 1u) * nx) xb_add(&bar[XB_TOPGEN], 1u);
            else XB_SPIN(xb_ld(&bar[XB_TOPGEN]) == tg, bar);
            xb_add(&bar[XB_XGEN(b.x)], 1u);
            __builtin_amdgcn_fence(__ATOMIC_ACQUIRE, "agent");
            asm volatile("s_waitcnt vmcnt(0)" ::: "memory");
        } else {
            XB_SPIN(xb_ld(&bar[XB_XGEN(b.x)]) == gen, bar);
            __builtin_amdgcn_fence(__ATOMIC_ACQUIRE, "agent");
            asm volatile("s_waitcnt vmcnt(0)" ::: "memory");
        }
    }
    __syncthreads();
}
#ifndef PROBE_PRO_REPS
#define PROBE_PRO_REPS 1
#endif
#ifndef PROBE_EWA_REPS
#define PROBE_EWA_REPS 1
#endif
#ifndef PROBE_EWB_REPS
#define PROBE_EWB_REPS 1
#endif
#ifndef PROBE_EWC_REPS
#define PROBE_EWC_REPS 1
#endif
#ifndef PROBE_GU_REPS
#define PROBE_GU_REPS 1
#endif
#ifndef PROBE_MIXA_REPS
#define PROBE_MIXA_REPS 1
#endif
#ifndef PROBE_MIXB_REPS
#define PROBE_MIXB_REPS 1
#endif
#ifndef PROBE_MIXC_REPS
#define PROBE_MIXC_REPS 1
#endif
#ifndef PROBE_SYNC_REPS
#define PROBE_SYNC_REPS 1
#endif
#define GSYNC() do { for (int r_ = 0; r_ < PROBE_SYNC_REPS; ++r_) { XcdBarrier xb_; xb_.bar = (unsigned*)(KARGS()->ws + WS_CTL); xb_.x = xb_xcc_id(); xb_.st = (volatile LAS unsigned*)(lds + MISC_OFF); xcd_barrier(xb_, wave_index(lds) == 0 && lane_id() == 0); } } while (0)
typedef const __attribute__((address_space(4))) Args* KArgP;
#define KARGS() ({ KArgP p_ = (KArgP)__builtin_amdgcn_kernarg_segment_ptr(); asm volatile("" : "+s"(p_)); p_; })
__device__ __forceinline__ void transpose_item(const float* W, int N, int k0, int n0, const float* g, bf16_t* WT, int ldk, int dst_row, LAS float* scr, int lane) {
    float v[32];
    const float* wp = W + (size_t)(k0 + (lane >> 5)) * N + n0 + (lane & 31);
#pragma unroll
    for (int i = 0; i < 32; ++i) v[i] = wp[(size_t)(2 * i) * N];
    if (g) {
        const float* gp = g + k0 + (lane >> 5);
#pragma unroll
        for (int i = 0; i < 32; ++i) v[i] *= gp[2 * i];
    }
#pragma unroll
    for (int i = 0; i < 32; ++i) scr[(2 * i + (lane >> 5)) * 33 + (lane & 31)] = v[i];
    asm volatile("s_waitcnt lgkmcnt(0)" ::: "memory");
    const int c = lane & 7;
#pragma unroll
    for (int j = 0; j < 4; ++j) { const int n = (lane >> 3) + 8 * j; const LAS float* s = scr + (8 * c) * 33 + n;
        u32x4 o; o.x = cvt_pk_bf16(s[0 * 33], s[1 * 33]); o.y = cvt_pk_bf16(s[2 * 33], s[3 * 33]); o.z = cvt_pk_bf16(s[4 * 33], s[5 * 33]); o.w = cvt_pk_bf16(s[6 * 33], s[7 * 33]);
        *(u32x4*)(WT + (size_t)(dst_row + n) * ldk + k0 + 8 * c) = o; }
    asm volatile("s_waitcnt lgkmcnt(0)" ::: "memory");
}
__device__ __forceinline__ float wave_sum(float v) {
#pragma unroll
    for (int o = 1; o < 64; o <<= 1) v += shx(v, o);
    return v;
}

constexpr int I_FFN_M = 1408, I_FFN = 3 * I_FFN_M, I_LAYER = 2 * I_FFN, I_ALLFFN = 4 * I_LAYER;
constexpr int I_EIN = 16 * 37, I_EQ = 6 * 24, I_EKV = 4 * 32, I_EOUT = 8 * 32, I_EVEN = I_EIN + I_EQ + I_EKV + I_EOUT;
constexpr int I_OIN = 16 * 96, I_OOUT = 16 * 32, I_ODD = I_OIN + I_OOUT;
__device__ __forceinline__ void convert_items(KArgP ap, LAS unsigned char* lds, int lo, int hi, int w, int nw, int wave, int lane) {
    unsigned char* ws = ap->ws;
    LAS float* scr = (LAS float*)(lds + wave * 16384);
    for (int it = lo + w; it < hi; it += nw) {
        int r = it;
        if (r < I_ALLFFN) {
            const int L = r / I_LAYER; r %= I_LAYER; const int f = r / I_FFN; r %= I_FFN; const int mtx = r / I_FFN_M; r %= I_FFN_M;
            bf16_t* wgu = (bf16_t*)(ws + WS_W + L * W_FFN_LAYER + f * (W_GU_BYTES + W_DN_BYTES)); bf16_t* wdn = (bf16_t*)((unsigned char*)wgu + W_GU_BYTES);
            const float* g = ap->in[f == 0 ? 1 : 6] + (size_t)L * D;
            if (mtx < 2) {
                const float* W = ap->in[(f == 0 ? 2 : 7) + mtx] + (size_t)L * D * FF;
                const int kb = r / 88, nb = r % 88, n0 = 32 * nb;
                transpose_item(W, FF, 64 * kb, n0, g, wgu, D, 256 * (n0 / 128) + (n0 % 128) + 128 * mtx, scr, lane);
            } else {
                const float* W = ap->in[f == 0 ? 4 : 9] + (size_t)L * FF * D;
                const int kb = r / 32, nb = r % 32;
                transpose_item(W, D, 64 * kb, 32 * nb, nullptr, wdn, FF, 32 * nb, scr, lane);
            }
            continue;
        }
        r -= I_ALLFFN;
        if (r < 2 * I_EVEN) {
            const int i = r / I_EVEN; r %= I_EVEN; const int L = 2 * i;
            unsigned char* wb = ws + WS_WEVEN + i * WE_STRIDE;
            if (r < I_EIN) { const int kb = r / 37, nb = r % 37;
                transpose_item(ap->in[10] + (size_t)i * D * 1184, 1184, 64 * kb, 32 * nb, ap->in[5] + (size_t)L * D, (bf16_t*)(wb + WE_IN), D, 32 * nb, scr, lane); continue; }
            r -= I_EIN;
            if (r < I_EQ) { const int kb = r / 24, nb = r % 24;
                transpose_item(ap->in[12] + (size_t)i * 384 * 768, 768, 64 * kb, 32 * nb, ap->in[11] + (size_t)i * 384, (bf16_t*)(wb + WE_Q), 384, 32 * nb, scr, lane); continue; }
            r -= I_EQ;
            if (r < I_EKV) { const int kb = r / 32, nb = r % 32, n0 = 32 * nb, hh = n0 / 128, w = n0 % 128;
                bf16_t* dst = (bf16_t*)(wb + (w < 64 ? WE_K : WE_V));
                transpose_item(ap->in[14] + (size_t)i * 256 * 1024, 1024, 64 * kb, n0, ap->in[13] + (size_t)i * 256, dst, 256, hh * 64 + (w & 63), scr, lane); continue; }
            r -= I_EKV;
            { const int kb = r / 32, nb = r % 32;
              transpose_item(ap->in[19] + (size_t)i * D * D, D, 512 + 64 * kb, 32 * nb, nullptr, (bf16_t*)(wb + WE_OUT), D, 32 * nb, scr, lane); }
            continue;
        }
        r -= 2 * I_EVEN;
        {
            const int i = r / I_ODD; r %= I_ODD; const int L = 2 * i + 1;
            unsigned char* wb = ws + WS_WODD + i * WO_STRIDE;
            if (r < I_OIN) { const int kb = r / 96, nb = r % 96, n0 = 32 * nb, seg = n0 / 1024, j = n0 % 1024;
                const int drow = (seg == 0) ? 2048 + j : 256 * (j / 128) + (j % 128) + (seg == 2 ? 128 : 0);
                transpose_item(ap->in[20] + (size_t)i * D * 3072, 3072, 64 * kb, n0, ap->in[5] + (size_t)L * D, (bf16_t*)(wb + WO_IN), D, drow, scr, lane); continue; }
            r -= I_OIN;
            { const int kb = r / 32, nb = r % 32;
              transpose_item(ap->in[22] + (size_t)i * D * D, D, 64 * kb, 32 * nb, nullptr, (bf16_t*)(wb + WO_OUT), D, 32 * nb, scr, lane); }
        }
    }
}
__device__ __forceinline__ void fold_jobs(KArgP ap, LAS unsigned char* lds, int i, int w, int nw, int wave, int lane) {
    unsigned char* ws = ap->ws;
    LAS float* scr = (LAS float*)(lds + wave * 16384);
    {
        const int gt = w * 64 + lane, ngt = nw * 64;
        for (int job = w; job < 1024; job += nw) {
            const int gg = (job >> 8) & 3, kch = (job >> 4) & 15, nb = job & 15, n = nb * 64 + lane;
            const float* wp = ap->in[17] + (size_t)i * 4 * 128 * 128 + ((size_t)gg * 128 + kch * 8) * 128;
            const float* sc = ap->in[18] + (size_t)i * 512 + gg * 128;
            const float* wo = ap->in[19] + (size_t)i * D * D + (size_t)gg * 128 * D + n;
            {
                f32x4 pv[4], sv[4];
#pragma unroll
                for (int q = 0; q < 4; ++q) { const int idx = (q * 64 + lane) * 4; pv[q] = *(const f32x4*)(wp + idx); sv[q] = *(const f32x4*)(sc + (idx & 127)); }
#pragma unroll
                for (int q = 0; q < 4; ++q) *(LAS f32x4*)(scr + (q * 64 + lane) * 4) = pv[q] * sv[q];
            }
            asm volatile("s_waitcnt lgkmcnt(0)" ::: "memory");
            float acc[8];
#pragma unroll
            for (int j = 0; j < 8; ++j) acc[j] = 0.f;
#pragma unroll 1
            for (int c0 = 0; c0 < 128; c0 += 16) {
                float wv[16];
#pragma unroll
                for (int ii = 0; ii < 16; ++ii) wv[ii] = wo[(size_t)(c0 + ii) * D];
                asm volatile("" ::: "memory");
#pragma unroll
                for (int ii = 0; ii < 16; ii += 4)
#pragma unroll
                    for (int j = 0; j < 8; ++j) { const f32x4 wq = *(const LAS f32x4*)(scr + j * 128 + c0 + ii);
                        acc[j] += (wq[0] * wv[ii] + wq[1] * wv[ii + 1]) + (wq[2] * wv[ii + 2] + wq[3] * wv[ii + 3]); }
            }
            u32x4 o; o.x = cvt_pk_bf16(acc[0], acc[1]); o.y = cvt_pk_bf16(acc[2], acc[3]); o.z = cvt_pk_bf16(acc[4], acc[5]); o.w = cvt_pk_bf16(acc[6], acc[7]);
            *(u32x4*)((bf16_t*)(ws + WS_WEVEN + i * WE_STRIDE + WE_OUT) + (size_t)n * D + gg * 128 + kch * 8) = o;
            asm volatile("s_waitcnt lgkmcnt(0)" ::: "memory");
        }
        unsigned zv = 0u; asm volatile("" : "+v"(zv));
        for (int idx = gt; idx < 96 * 128; idx += ngt)
            ((u32x4*)(ws + WS_WEVEN + i * WE_STRIDE + WE_IN + (size_t)1184 * D * 2))[idx] = (u32x4){zv, zv, zv, zv};
    }
}
__device__ __forceinline__ void x_init(KArgP ap, int gw, int ngw, int lane) {
    unsigned char* ws = ap->ws;
    {
        const float* __restrict__ x = ap->in[0]; bf16_t* __restrict__ xb = (bf16_t*)(ws + WS_XB); float* __restrict__ ssq = (float*)(ws + WS_SSQ);
#pragma unroll 2
        for (int m = gw; m < S; m += ngw) {
            const f32x4* xr = (const f32x4*)(x + (size_t)m * D) + lane; float s = 0.f;
            u32x2* o8 = (u32x2*)(xb + (size_t)m * D) + lane;
#pragma unroll
            for (int j = 0; j < 4; ++j) { const f32x4 v = xr[64 * j]; s += (v[0] * v[0] + v[1] * v[1]) + (v[2] * v[2] + v[3] * v[3]); u32x2 w; w.x = cvt_pk_bf16(v[0], v[1]); w.y = cvt_pk_bf16(v[2], v[3]); o8[64 * j] = w; }
            s = wave_sum(s);
            if (lane < 16) ssq[(size_t)m * 16 + lane] = (lane == 0) ? s : 0.f;
        }
    }
}

__device__ __forceinline__ void convert_layer_half(KArgP ap, LAS unsigned char* lds, int Ln, int f, int w, int nw, int wave, int lane) {
    convert_items(ap, lds, Ln * I_LAYER + f * I_FFN, Ln * I_LAYER + (f + 1) * I_FFN, w, nw, wave, lane);
    if (f == 0) {
        const int i = Ln >> 1;
        if ((Ln & 1) == 0) { convert_items(ap, lds, I_ALLFFN + i * I_EVEN, I_ALLFFN + (i + 1) * I_EVEN, w, nw, wave, lane); fold_jobs(ap, lds, i, w, nw, wave, lane); }
        else convert_items(ap, lds, I_ALLFFN + 2 * I_EVEN + i * I_ODD, I_ALLFFN + 2 * I_EVEN + (i + 1) * I_ODD, w, nw, wave, lane);
    }
}
__device__ __forceinline__ void convert_chunk(KArgP ap, LAS unsigned char* lds, int k, int w, int nw, int wave, int lane) {
    if (k == 1) convert_items(ap, lds, 2 * I_FFN_M, I_LAYER, w, nw, wave, lane);
    else if (k <= 7) convert_layer_half(ap, lds, k >> 1, k & 1, w, nw, wave, lane);
}
__device__ __forceinline__ void prologue(KArgP ap, LAS unsigned char* lds, int gw, int ngw, int wave, int lane) {
    convert_items(ap, lds, 0, 2 * I_FFN_M, gw, ngw, wave, lane);
    convert_items(ap, lds, I_ALLFFN, I_ALLFFN + I_EVEN, gw, ngw, wave, lane);
    fold_jobs(ap, lds, 0, gw, ngw, wave, lane);
    x_init(ap, gw, ngw, lane);
}

__device__ __forceinline__ void pool_stats_phase(const bf16_t* __restrict__ Z, bf16_t* __restrict__ AO, float* __restrict__ RS, int gw, int ngw, int lane) {
    const int c0 = lane * 8, w = 2 << (lane >> 4);
#pragma unroll 2
    for (int t = gw; t < S; t += ngw) {
        const bf16_t* zr = Z + (size_t)t * ZW;
        const unsigned* pq = (const unsigned*)(zr + 512 + lane * 6); const unsigned qa = pq[0], qb = pq[1], qc = pq[2];
        const unsigned* pk = (const unsigned*)(zr + 896 + lane * 4); const unsigned ka = pk[0], kb = pk[1];
        u32x4 v[16];
#pragma unroll
        for (int j = 0; j < 16; ++j) { const int rr = (t - j) > 0 ? (t - j) : 0; v[j] = *(const u32x4*)(Z + (size_t)rr * ZW + c0); }
        { float s = bf_lo(qa) * bf_lo(qa) + bf_hi(qa) * bf_hi(qa) + bf_lo(qb) * bf_lo(qb) + bf_hi(qb) * bf_hi(qb) + bf_lo(qc) * bf_lo(qc) + bf_hi(qc) * bf_hi(qc);
          s = wave_sum(s); if (lane == 0) RS[(size_t)t * 2] = __builtin_amdgcn_rsqf(s * (1.0f / 384.0f) + EPS); }
        { float s = bf_lo(ka) * bf_lo(ka) + bf_hi(ka) * bf_hi(ka) + bf_lo(kb) * bf_lo(kb) + bf_hi(kb) * bf_hi(kb);
          s = wave_sum(s); if (lane == 0) RS[(size_t)t * 2 + 1] = __builtin_amdgcn_rsqf(s * (1.0f / 256.0f) + EPS); }
        float a0 = 0.f, a1 = 0.f, a2 = 0.f, a3 = 0.f, a4 = 0.f, a5 = 0.f, a6 = 0.f, a7 = 0.f;
#pragma unroll
        for (int j = 0; j < 16; ++j) {
            const float mk = (j < w && j <= t) ? 1.0f : 0.0f;
            a0 += mk * bf_lo(v[j].x); a1 += mk * bf_hi(v[j].x); a2 += mk * bf_lo(v[j].y); a3 += mk * bf_hi(v[j].y);
            a4 += mk * bf_lo(v[j].z); a5 += mk * bf_hi(v[j].z); a6 += mk * bf_lo(v[j].w); a7 += mk * bf_hi(v[j].w);
        }
        const float ic = 1.0f / (float)((t + 1 < w) ? (t + 1) : w);
        const u32x4 cur = v[0];
        u32x4 o; o.x = cvt_pk_bf16(a0 * ic - bf_lo(cur.x), a1 * ic - bf_hi(cur.x)); o.y = cvt_pk_bf16(a2 * ic - bf_lo(cur.y), a3 * ic - bf_hi(cur.y));
        o.z = cvt_pk_bf16(a4 * ic - bf_lo(cur.z), a5 * ic - bf_hi(cur.z)); o.w = cvt_pk_bf16(a6 * ic - bf_lo(cur.w), a7 * ic - bf_hi(cur.w));
        *(u32x4*)(AO + (size_t)t * D + c0) = o;
    }
}

__device__ __forceinline__ void qk_prep_phase(const bf16_t* __restrict__ QP, const bf16_t* __restrict__ KP, const bf16_t* __restrict__ Z, const float* __restrict__ qhn, const float* __restrict__ khn, bf16_t* __restrict__ Q, bf16_t* __restrict__ K, int gt, int ngt) {
    const float QSC = 0.10206207261596577f * 1.4426950408889634f;
    const int q4 = gt & 3;
    for (int item = gt >> 2; item < S * NH; item += ngt >> 2) {
        const int t = item >> 3, h = item & 7;
        u32x4 qv[3], kv[3];
        { const u32x4* p = (const u32x4*)(QP + (size_t)t * 768 + h * 96) + q4; qv[0] = p[0]; qv[1] = p[4]; qv[2] = p[8]; }
        { const u32x4* p = (const u32x4*)(KP + (size_t)t * 512 + h * 64) + q4; kv[0] = p[0]; kv[1] = p[4]; kv[2] = ((const u32x4*)(Z + (size_t)t * ZW + 1152))[q4]; }
        float cs[8], sn[8];
#pragma unroll
        for (int j = 0; j < 8; ++j) {
            const int i = 8 * (q4 & 1) + j;
            const float inv_freq = exp2f(-(float)i * (13.287712379549449f / 16.0f));
            const double rev = (double)t * (double)inv_freq * 0.15915494309189535;
            const float fr = (float)(rev - rint(rev));
            cs[j] = __builtin_amdgcn_cosf(fr); sn[j] = __builtin_amdgcn_sinf(fr);
        }
#pragma unroll
        for (int which = 0; which < 2; ++which) {
            const u32x4* v = which == 0 ? qv : kv; const float* gn = which == 0 ? qhn : khn;
            float ss = 0.f;
#pragma unroll
            for (int c = 0; c < 3; ++c) { const u32x4 x = v[c];
                ss += (bf_lo(x.x) * bf_lo(x.x) + bf_hi(x.x) * bf_hi(x.x)) + (bf_lo(x.y) * bf_lo(x.y) + bf_hi(x.y) * bf_hi(x.y)) + (bf_lo(x.z) * bf_lo(x.z) + bf_hi(x.z) * bf_hi(x.z)) + (bf_lo(x.w) * bf_lo(x.w) + bf_hi(x.w) * bf_hi(x.w)); }
            ss += shx(ss, 1); ss += shx(ss, 2);
            const float rs = __builtin_amdgcn_rsqf(ss * (1.0f / 96.0f) + EPS) * (which == 0 ? QSC : 1.0f);
            u32x4* dst = (u32x4*)((which == 0 ? Q : K) + ((size_t)h * S + t) * DQK) + q4;
#pragma unroll
            for (int c = 0; c < 2; ++c) {
                const u32x4 x = v[c]; const float* g = gn + 8 * q4 + 32 * c; const f32x4 g0 = *(const f32x4*)g, g1 = *(const f32x4*)(g + 4);
                u32x4 o; o.x = cvt_pk_bf16(bf_lo(x.x) * rs * g0[0], bf_hi(x.x) * rs * g0[1]); o.y = cvt_pk_bf16(bf_lo(x.y) * rs * g0[2], bf_hi(x.y) * rs * g0[3]);
                o.z = cvt_pk_bf16(bf_lo(x.z) * rs * g1[0], bf_hi(x.z) * rs * g1[1]); o.w = cvt_pk_bf16(bf_lo(x.w) * rs * g1[2], bf_hi(x.w) * rs * g1[3]);
                dst[4 * c] = o;
            }
            {
                const u32x4 xo = v[2];
                u32x4 xp; xp.x = shx(xo.x, 2); xp.y = shx(xo.y, 2); xp.z = shx(xo.z, 2); xp.w = shx(xo.w, 2);
                const float* go = gn + 64 + 8 * q4; const float* gp = gn + 64 + 8 * (q4 ^ 2);
                const f32x4 go0 = *(const f32x4*)go, go1 = *(const f32x4*)(go + 4), gp0 = *(const f32x4*)gp, gp1 = *(const f32x4*)(gp + 4);
                const float a[8] = {bf_lo(xo.x) * rs * go0[0], bf_hi(xo.x) * rs * go0[1], bf_lo(xo.y) * rs * go0[2], bf_hi(xo.y) * rs * go0[3], bf_lo(xo.z) * rs * go1[0], bf_hi(xo.z) * rs * go1[1], bf_lo(xo.w) * rs * go1[2], bf_hi(xo.w) * rs * go1[3]};
                const float b[8] = {bf_lo(xp.x) * rs * gp0[0], bf_hi(xp.x) * rs * gp0[1], bf_lo(xp.y) * rs * gp0[2], bf_hi(xp.y) * rs * gp0[3], bf_lo(xp.z) * rs * gp1[0], bf_hi(xp.z) * rs * gp1[1], bf_lo(xp.w) * rs * gp1[2], bf_hi(xp.w) * rs * gp1[3]};
                const float sg = (q4 < 2) ? -1.0f : 1.0f;
                float y[8];
#pragma unroll
                for (int j = 0; j < 8; ++j) y[j] = a[j] * cs[j] + sg * b[j] * sn[j];
                u32x4 o; o.x = cvt_pk_bf16(y[0], y[1]); o.y = cvt_pk_bf16(y[2], y[3]); o.z = cvt_pk_bf16(y[4], y[5]); o.w = cvt_pk_bf16(y[6], y[7]);
                dst[8] = o;
            }
        }
    }
}

__device__ __forceinline__ void conv_phase(const bf16_t* __restrict__ U, const bf16_t* __restrict__ GB, const float* __restrict__ cw, bf16_t* __restrict__ AO, int gt, int ngt) {
    const int c0 = (gt & 127) * 8;
    const f32x4 wa0 = *(const f32x4*)(cw + c0), wa1 = *(const f32x4*)(cw + c0 + 4);
    const f32x4 wb0 = *(const f32x4*)(cw + D + c0), wb1 = *(const f32x4*)(cw + D + c0 + 4);
    const f32x4 wc0 = *(const f32x4*)(cw + 2 * D + c0), wc1 = *(const f32x4*)(cw + 2 * D + c0 + 4);
#pragma unroll 4
    for (int idx = gt; idx < S * 128; idx += ngt) {
        const int t = idx >> 7;
        const int t1 = t >= 1 ? t - 1 : 0, t2 = t >= 2 ? t - 2 : 0;
        const float m1 = t >= 1 ? 1.0f : 0.0f, m2 = t >= 2 ? 1.0f : 0.0f;
        const u32x4 u0 = *(const u32x4*)(U + (size_t)t * D + c0);
        const u32x4 u1 = *(const u32x4*)(U + (size_t)t1 * D + c0);
        const u32x4 u2 = *(const u32x4*)(U + (size_t)t2 * D + c0);
        const u32x4 gb = *(const u32x4*)(GB + (size_t)t * D + c0);
        float y[8];
        y[0] = m2 * wa0[0] * bf_lo(u2.x) + m1 * wb0[0] * bf_lo(u1.x) + wc0[0] * bf_lo(u0.x);
        y[1] = m2 * wa0[1] * bf_hi(u2.x) + m1 * wb0[1] * bf_hi(u1.x) + wc0[1] * bf_hi(u0.x);
        y[2] = m2 * wa0[2] * bf_lo(u2.y) + m1 * wb0[2] * bf_lo(u1.y) + wc0[2] * bf_lo(u0.y);
        y[3] = m2 * wa0[3] * bf_hi(u2.y) + m1 * wb0[3] * bf_hi(u1.y) + wc0[3] * bf_hi(u0.y);
        y[4] = m2 * wa1[0] * bf_lo(u2.z) + m1 * wb1[0] * bf_lo(u1.z) + wc1[0] * bf_lo(u0.z);
        y[5] = m2 * wa1[1] * bf_hi(u2.z) + m1 * wb1[1] * bf_hi(u1.z) + wc1[1] * bf_hi(u0.z);
        y[6] = m2 * wa1[2] * bf_lo(u2.w) + m1 * wb1[2] * bf_lo(u1.w) + wc1[2] * bf_lo(u0.w);
        y[7] = m2 * wa1[3] * bf_hi(u2.w) + m1 * wb1[3] * bf_hi(u1.w) + wc1[3] * bf_hi(u0.w);
        u32x4 o; o.x = cvt_pk_bf16(bf_lo(gb.x) * y[0], bf_hi(gb.x) * y[1]); o.y = cvt_pk_bf16(bf_lo(gb.y) * y[2], bf_hi(gb.y) * y[3]);
        o.z = cvt_pk_bf16(bf_lo(gb.z) * y[4], bf_hi(gb.z) * y[5]); o.w = cvt_pk_bf16(bf_lo(gb.w) * y[6], bf_hi(gb.w) * y[7]);
        *(u32x4*)(AO + (size_t)t * D + c0) = o;
    }
}

struct Ids { int lane, wave, vcu, gw, ngw, gt, ngt, G, bx; };
__device__ __forceinline__ Ids make_ids(LAS unsigned char* lds) {
    Ids d; d.wave = wave_index(lds); int tid = d.wave * 64 + lane_id(); asm volatile("" : "+v"(tid));
    d.lane = tid & 63;
    d.G = gridDim.x; d.bx = blockIdx.x; asm volatile("" : "+s"(d.G), "+s"(d.bx));
    d.vcu = (d.G % 8 == 0) ? (d.bx % 8) * (d.G / 8) + d.bx / 8 : d.bx;
    d.gw = d.vcu * 8 + d.wave; d.ngw = d.G * 8; d.gt = d.gw * 64 + d.lane; d.ngt = d.ngw * 64;
    return d;
}

__global__ void __launch_bounds__(512, 2) fwd_megakernel(Args a_unused) {
    extern __shared__ __attribute__((aligned(16))) unsigned char lds_raw[];
    LAS unsigned char* lds = (LAS unsigned char*)lds_raw;

    {
        const int w_ = __builtin_amdgcn_readfirstlane((int)threadIdx.x >> 6);
        if (lane_id() == 0) ((volatile LAS int*)(lds + WTAB_OFF))[hw_slot()] = w_;
        if (w_ == 0 && lane_id() < 2) ((volatile LAS unsigned*)(lds + MISC_OFF))[lane_id()] = 0u;
    }
    __syncthreads();
    (void)xcd_barrier_post((unsigned*)(KARGS()->ws + WS_CTL), (volatile LAS unsigned*)(lds + MISC_OFF), wave_index(lds) == 0 && lane_id() == 0);
    { const Ids d = make_ids(lds); KArgP k = KARGS();
      for (int rep = 0; rep < PROBE_PRO_REPS; ++rep) prologue(k, lds, d.gw, d.ngw, d.wave, d.lane); }
    if (a_unused.ws == nullptr) cg::this_grid().sync();
    GSYNC();

#pragma unroll 1
    for (int L = 0; L < DEPTH; ++L) {
#pragma unroll 1
        for (int f = 0; f < 2; ++f) {
            {
                KArgP k = KARGS(); unsigned char* ws = k->ws;
                const bf16_t* wgu = (const bf16_t*)(ws + WS_W + L * W_FFN_LAYER + f * (W_GU_BYTES + W_DN_BYTES));
                pg8::Gemm g{(const bf16_t*)(ws + WS_XB), wgu, S, 2 * FF, D, D, D}; pg8::StaticOrder so; so.init(S, 2 * FF, gridDim.x, blockIdx.x);
                pg8::EpiSwiGLU E{(bf16_t*)(ws + WS_H), (const float*)(ws + WS_SSQ), lds};
                for (int rep = 0; rep < PROBE_GU_REPS; ++rep) pg8::gemm_phase<pg8::EpiSwiGLU>(lds, g, so, E);
                {
                    const Ids d = make_ids(lds); const int half = d.G / 2;
                    if (d.bx >= half) convert_chunk(KARGS(), lds, 2 * L + f + 1, (d.bx - half) * 8 + d.wave, (d.G - half) * 8, d.wave, d.lane);
                }
            }
            GSYNC();
            {
                KArgP k = KARGS(); unsigned char* ws = k->ws; float* out = k->out;
                const bf16_t* wdn = (const bf16_t*)(ws + WS_W + L * W_FFN_LAYER + f * (W_GU_BYTES + W_DN_BYTES) + W_GU_BYTES);
                pg8::Gemm g{(const bf16_t*)(ws + WS_H), wdn, S, D, FF, FF, FF}; pg8::StaticOrder so; so.init(S, D, gridDim.x, blockIdx.x);
                pg8::EpiResid E{(L == DEPTH - 1 && f == 1) ? out : (float*)nullptr, (bf16_t*)(ws + WS_XB), (float*)(ws + WS_SSQ), 0.5f};
                pg8::gemm_phase<pg8::EpiResid>(lds, g, so, E);
#ifdef PROBE_DN
                { GSYNC(); pg8::EpiResid E2{(float*)nullptr, (bf16_t*)(ws + WS_XB), (float*)(ws + WS_SSQ), 0.0f}; pg8::gemm_phase<pg8::EpiResid>(lds, g, so, E2); }
#endif
            }
            GSYNC();
            if (f == 1) break;
            const int i = L >> 1;
            if ((L & 1) == 0) {
                {
                    KArgP k = KARGS(); unsigned char* ws = k->ws; unsigned char* wb = ws + WS_WEVEN + i * WE_STRIDE;
                    pg8::Gemm g{(const bf16_t*)(ws + WS_XB), (const bf16_t*)(wb + WE_IN), S, ZW, D, D, D}; pg8::StaticOrder so; so.init(S, ZW, gridDim.x, blockIdx.x);
                    pg8::EpiRowBf16<0> E{(bf16_t*)(ws + WS_Z), ZW, (const float*)(ws + WS_SSQ), 0, lds};
                    for (int rep_ = 0; rep_ < PROBE_MIXA_REPS; ++rep_) pg8::gemm_phase<pg8::EpiRowBf16<0>>(lds, g, so, E);
                }
                GSYNC();
                { KArgP k = KARGS(); unsigned char* ws = k->ws; const Ids d = make_ids(lds);
                  for (int rep = 0; rep < PROBE_EWA_REPS; ++rep) pool_stats_phase((const bf16_t*)(ws + WS_Z), (bf16_t*)(ws + WS_AO), (float*)(ws + WS_RS), d.gw, d.ngw, d.lane); }
                GSYNC();
                {
                    KArgP k = KARGS(); unsigned char* ws = k->ws; unsigned char* wb = ws + WS_WEVEN + i * WE_STRIDE;
                    pg8::Gemm g{(const bf16_t*)(ws + WS_Z) + 512, (const bf16_t*)(wb + WE_Q), S, 768, 384, ZW, 384}; pg8::StaticOrder so; so.init(S, 768, gridDim.x, blockIdx.x);
                    pg8::EpiRowBf16<1> E{(bf16_t*)(ws + WS_QP), 768, (const float*)(ws + WS_RS), 0, lds};
                    for (int rep_ = 0; rep_ < PROBE_MIXB_REPS; ++rep_) pg8::gemm_phase<pg8::EpiRowBf16<1>>(lds, g, so, E);
                }
                {
                    KArgP k = KARGS(); unsigned char* ws = k->ws; unsigned char* wb = ws + WS_WEVEN + i * WE_STRIDE;
                    pg8::Gemm g{(const bf16_t*)(ws + WS_Z) + 896, (const bf16_t*)(wb + WE_K), S, 512, 256, ZW, 256}; pg8::StaticOrder so; so.init(S, 512, gridDim.x, (blockIdx.x + gridDim.x / 2) % gridDim.x);
                    pg8::EpiRowBf16<1> E{(bf16_t*)(ws + WS_KP), 512, (const float*)(ws + WS_RS), 1, lds};
                    for (int rep_ = 0; rep_ < PROBE_MIXB_REPS; ++rep_) pg8::gemm_phase<pg8::EpiRowBf16<1>>(lds, g, so, E);
                }
                {
                    KArgP k = KARGS(); unsigned char* ws = k->ws; unsigned char* wb = ws + WS_WEVEN + i * WE_STRIDE;
                    pg8::Gemm g{(const bf16_t*)(wb + WE_V), (const bf16_t*)(ws + WS_Z) + 896, 512, S, 256, 256, ZW}; pg8::StaticOrder so; so.init(512, S, gridDim.x, (blockIdx.x + 3 * gridDim.x / 4) % gridDim.x);
                    pg8::EpiColBf16 E{(bf16_t*)(ws + WS_VT), S, (const float*)(ws + WS_RS)};
                    for (int rep_ = 0; rep_ < PROBE_MIXB_REPS; ++rep_) pg8::gemm_phase<pg8::EpiColBf16>(lds, g, so, E);
                }
                GSYNC();
                { KArgP k = KARGS(); unsigned char* ws = k->ws; const Ids d = make_ids(lds);
                  for (int rep = 0; rep < PROBE_EWB_REPS; ++rep) qk_prep_phase((const bf16_t*)(ws + WS_QP), (const bf16_t*)(ws + WS_KP), (const bf16_t*)(ws + WS_Z), k->in[15] + (size_t)i * DQK, k->in[16] + (size_t)i * DQK,
                                (bf16_t*)(ws + WS_Q), (bf16_t*)(ws + WS_K), d.gt, d.ngt); }
                GSYNC();
                {
                    KArgP k = KARGS(); unsigned char* ws = k->ws; const Ids d = make_ids(lds);
                    const int h = (d.vcu >> 5) & 7, s = d.vcu & 31;
#ifndef PROBE_ATT_REPS
#define PROBE_ATT_REPS 1
#endif
                    if (d.vcu < 256) for (int rep = 0; rep < PROBE_ATT_REPS; ++rep) {
                        att::attn_unit<0>(h, 63 - s, (const bf16_t*)(ws + WS_Q), (const bf16_t*)(ws + WS_K), (const bf16_t*)(ws + WS_VT), (bf16_t*)(ws + WS_AO), lds);
                        att::attn_unit<0>(h, s, (const bf16_t*)(ws + WS_Q), (const bf16_t*)(ws + WS_K), (const bf16_t*)(ws + WS_VT), (bf16_t*)(ws + WS_AO), lds);
                    }
#ifdef PROBE_ATT_VAR
                    if (d.vcu < 256) {
                        att::attn_unit<PROBE_ATT_VAR>(h, 63 - s, (const bf16_t*)(ws + WS_Q), (const bf16_t*)(ws + WS_K), (const bf16_t*)(ws + WS_VT), (bf16_t*)(ws + WS_QP), lds);
                        att::attn_unit<PROBE_ATT_VAR>(h, s, (const bf16_t*)(ws + WS_Q), (const bf16_t*)(ws + WS_K), (const bf16_t*)(ws + WS_VT), (bf16_t*)(ws + WS_QP), lds);
                    }
#endif
                }
                GSYNC();
                {
                    KArgP k = KARGS(); unsigned char* ws = k->ws; float* out = k->out; unsigned char* wb = ws + WS_WEVEN + i * WE_STRIDE;
                    pg8::Gemm g{(const bf16_t*)(ws + WS_AO), (const bf16_t*)(wb + WE_OUT), S, D, D, D, D}; pg8::StaticOrder so; so.init(S, D, gridDim.x, blockIdx.x);
                    pg8::EpiResid E{(float*)nullptr, (bf16_t*)(ws + WS_XB), (float*)(ws + WS_SSQ), 1.0f};
                    pg8::gemm_phase<pg8::EpiResid>(lds, g, so, E);
#ifdef PROBE_MIXOUT
                    { pg8::EpiResid E2{(float*)nullptr, (bf16_t*)(ws + WS_XB), (float*)(ws + WS_SSQ), 0.0f}; pg8::gemm_phase<pg8::EpiResid>(lds, g, so, E2); }
#endif
                }
                GSYNC();
            } else {
                {
                    KArgP k = KARGS(); unsigned char* ws = k->ws; unsigned char* wb = ws + WS_WODD + i * WO_STRIDE;
                    pg8::Gemm g{(const bf16_t*)(ws + WS_XB), (const bf16_t*)(wb + WO_IN), S, 3 * D, D, D, D}; pg8::StaticOrder so; so.init(S, 3 * D, gridDim.x, blockIdx.x);
                    pg8::EpiConvIn E{(bf16_t*)(ws + WS_U), (bf16_t*)(ws + WS_GB), (const float*)(ws + WS_SSQ), lds};
                    for (int rep_ = 0; rep_ < PROBE_MIXC_REPS; ++rep_) pg8::gemm_phase<pg8::EpiConvIn>(lds, g, so, E);
                }
                GSYNC();
                { KArgP k = KARGS(); unsigned char* ws = k->ws; const Ids d = make_ids(lds);
                  for (int rep = 0; rep < PROBE_EWC_REPS; ++rep) conv_phase((const bf16_t*)(ws + WS_U), (const bf16_t*)(ws + WS_GB), k->in[21] + (size_t)i * 3 * D, (bf16_t*)(ws + WS_AO), d.gt, d.ngt); }
                GSYNC();
                {
                    KArgP k = KARGS(); unsigned char* ws = k->ws; float* out = k->out; unsigned char* wb = ws + WS_WODD + i * WO_STRIDE;
                    pg8::Gemm g{(const bf16_t*)(ws + WS_AO), (const bf16_t*)(wb + WO_OUT), S, D, D, D, D}; pg8::StaticOrder so; so.init(S, D, gridDim.x, blockIdx.x);
                    pg8::EpiResid E{(float*)nullptr, (bf16_t*)(ws + WS_XB), (float*)(ws + WS_SSQ), 1.0f};
                    pg8::gemm_phase<pg8::EpiResid>(lds, g, so, E);
#ifdef PROBE_MIXOUT
                    { pg8::EpiResid E2{(float*)nullptr, (bf16_t*)(ws + WS_XB), (float*)(ws + WS_SSQ), 0.0f}; pg8::gemm_phase<pg8::EpiResid>(lds, g, so, E2); }
#endif
                }
                GSYNC();
            }
        }
    }
}

extern "C" void kernel_launch(void* const* d_in, const int* in_sizes, int n_in, void* d_out, int out_size, void* d_ws, size_t ws_size, hipStream_t stream) {
    static int grid = 0;
    if (grid == 0) {
        if (n_in != 23 || out_size != S * D || ws_size < WS_END) { fprintf(stderr, "kernel_launch: unexpected shapes (n_in %d out %d ws %zu need %zu)\n", n_in, out_size, ws_size, (size_t)WS_END); grid = -1; return; }
        int dev = 0, cus = 0, per_cu = 0;
        hipGetDevice(&dev);
        hipDeviceGetAttribute(&cus, hipDeviceAttributeMultiprocessorCount, dev);
        if (hipFuncSetAttribute((const void*)fwd_megakernel, hipFuncAttributeMaxDynamicSharedMemorySize, LDS_BYTES) != hipSuccess) { fprintf(stderr, "hipFuncSetAttribute failed\n"); grid = -1; return; }
        hipOccupancyMaxActiveBlocksPerMultiprocessor(&per_cu, (const void*)fwd_megakernel, 512, LDS_BYTES);
        (void)hipGetLastError();
        if (per_cu < 1) per_cu = 1;
        grid = cus;
        if (grid > 256) grid = 256;
    }
    if (grid < 0) return;
    if (hipMemsetAsync((char*)d_ws + WS_CTL, 0, CTL_BYTES, stream) != hipSuccess) { fprintf(stderr, "memset failed\n"); return; }
    Args a{};
    for (int i = 0; i < 23; ++i) a.in[i] = (const float*)d_in[i];
    a.out = (float*)d_out; a.ws = (unsigned char*)d_ws;
    void* args[] = {&a};
    hipError_t e = hipLaunchCooperativeKernel((const void*)fwd_megakernel, dim3(grid), dim3(512), args, LDS_BYTES, stream);
    if (e != hipSuccess) fprintf(stderr, "cooperative launch failed: %s (grid %d)\n", hipGetErrorString(e), grid);
}
```

```cpp
#include <hip/hip_runtime.h>
#include <hip/hip_cooperative_groups.h>
#include <cstdio>
#include <cstdint>
namespace cg = cooperative_groups;

#define LAS __attribute__((address_space(3)))
typedef unsigned short bf16_t;
typedef short bf16x8 __attribute__((ext_vector_type(8)));
typedef short s16x4 __attribute__((ext_vector_type(4)));
typedef float f32x4 __attribute__((ext_vector_type(4)));
typedef float f32x16 __attribute__((ext_vector_type(16)));
typedef unsigned u32x4 __attribute__((ext_vector_type(4)));
typedef unsigned u32x2 __attribute__((ext_vector_type(2)));

constexpr int S = 16384, D = 1024, FF = 2816, DEPTH = 4;
constexpr int ZW = 1280;
constexpr int NH = 8, DQK = 96, DV = 64;
constexpr float EPS = 1e-6f;

__device__ __forceinline__ unsigned cvt_pk_bf16(float lo, float hi) { unsigned r; asm volatile("v_cvt_pk_bf16_f32 %0, %1, %2" : "=v"(r) : "v"(lo), "v"(hi)); return r; }
__device__ __forceinline__ float bf_lo(unsigned w) { return __uint_as_float(w << 16); }
__device__ __forceinline__ float bf_hi(unsigned w) { return __uint_as_float(w & 0xffff0000u); }
__device__ __forceinline__ float bf_one(bf16_t v) { return __uint_as_float(((unsigned)v) << 16); }
__device__ __forceinline__ bf16_t f2bf(float f) { return (bf16_t)(cvt_pk_bf16(f, 0.f) & 0xffffu); }

constexpr int WTAB_OFF = 131072 + 64 + 2048;
__device__ __forceinline__ int lane_id() { int l = (int)__builtin_amdgcn_mbcnt_hi(~0u, __builtin_amdgcn_mbcnt_lo(~0u, 0u)); asm volatile("" : "+v"(l)); return l; }
__device__ __forceinline__ int shx(int v, int m) { return __builtin_amdgcn_ds_bpermute((lane_id() ^ m) << 2, v); }
__device__ __forceinline__ unsigned shx(unsigned v, int m) { return (unsigned)__builtin_amdgcn_ds_bpermute((lane_id() ^ m) << 2, (int)v); }
__device__ __forceinline__ float shx(float v, int m) { return __int_as_float(__builtin_amdgcn_ds_bpermute((lane_id() ^ m) << 2, __float_as_int(v))); }
__device__ __forceinline__ unsigned hw_slot() { return (unsigned)__builtin_amdgcn_s_getreg((5 << 11) | 4) & 0x3fu; }
__device__ __forceinline__ int wave_index(LAS unsigned char* lds) { return __builtin_amdgcn_readfirstlane(((volatile LAS int*)(lds + WTAB_OFF))[hw_slot()]); }
namespace pg8 {
constexpr int BM = 256, BK = 64, HALF = 128, HTB = HALF * BK * 2, STAGE_BYTES = 8 * HTB, NXCD = 8, WGM = 8;
__host__ __device__ __forceinline__ int lds_byte(int r, int c) { const int st = (r >> 4) * 2 + (c >> 5), rr = r & 15, cc = c & 31, ob = rr * 64 + cc * 2; return st * 1024 + (ob ^ (((ob >> 9) & 1) << 5)); }
__host__ __device__ __forceinline__ void stage_rc(int b, int& R, int& C) { const int st = b / 1024, sb = b % 1024, swz = sb ^ (((sb >> 9) & 1) << 5); R = (st >> 1) * 16 + swz / 64; C = (st & 1) * 32 + (swz % 64) / 2; }
__host__ __device__ __forceinline__ int perm32(int rho) { const int n = rho >> 4, i = rho & 15; return 8 * (i >> 2) + 4 * n + (i & 3); }

struct Unit { int pm, pn; };
struct Gemm { const bf16_t* A; const bf16_t* Bt; int M, N, K, lda, ldb; };

struct StaticOrder {
    int nM, nN, nwg, G, c;
    __device__ __forceinline__ void init(int M, int N, int G_, int c_) { nM = M / BM; nN = N / BM; nwg = nM * nN; G = G_; c = c_; asm volatile("" : "+s"(c)); }
    __device__ __forceinline__ bool next(int i, Unit& u) const {
        const long L = (long)i * G + c; if (L >= nwg) return false;
        int wgid = (int)L; { const int q = nwg / NXCD, r = nwg % NXCD, xcd = wgid % NXCD, off = wgid / NXCD; wgid = (xcd < r ? xcd * (q + 1) : r * (q + 1) + (xcd - r) * q) + off; }
        const int nig = WGM * nN, gid = wgid / nig, fm = gid * WGM, gsz = (nM - fm) < WGM ? (nM - fm) : WGM;
        u.pm = fm + ((wgid % nig) % gsz); u.pn = (wgid % nig) / gsz; return true;
    }
};

template <class Epi, bool ALIGN_EPI = true, bool SP2 = true>
__device__ __forceinline__ void gemm_phase(LAS unsigned char* lds, const Gemm g, const StaticOrder& S, const Epi& E) {
    const int wid = wave_index(lds); int tid_ = wid * 64 + lane_id(); asm volatile("" : "+v"(tid_));
    const int tid = tid_, lane = tid & 63, wr = wid >> 2, wc = wid & 3, fr = lane & 15, fq = lane >> 4;
    const int K = g.K, nt = K / BK;
    unsigned voffA[2], voffB[2];
#pragma unroll
    for (int i = 0; i < 2; ++i) { int R, C; stage_rc(tid * 16 + i * 8192, R, C); const int Rb = Epi::PERM ? ((R & ~31) + perm32(R & 31)) : R;
        voffA[i] = (unsigned)(R * g.lda + C) * 2u; voffB[i] = (unsigned)(Rb * g.ldb + C) * 2u; }
    const size_t kstep = (size_t)(BK * 2);
    const size_t hstepA = (size_t)HALF * g.lda * 2, hstepB = (size_t)HALF * g.ldb * 2;
    const size_t tstepA = 2 * hstepA, tstepB = 2 * hstepB;
    const unsigned ldsw = (unsigned)wid * 1024u;
    const int aoff = lds_byte(wr * 64 + fr, fq * 8), boff = lds_byte(wc * 32 + fr, fq * 8);
#define PG8_SA(b, h) (((b) * 2 + (h)) * HTB)
#define PG8_SB(b, h) ((4 + (b) * 2 + (h)) * HTB)
#define PG8_STAGE(bufoff, gbase, voff) do { _Pragma("unroll") for (int _i = 0; _i < 2; ++_i) \
        __builtin_amdgcn_global_load_lds((const unsigned*)((const char*)(gbase) + (voff)[_i]), (LAS unsigned*)(lds + (bufoff) + ldsw + _i * 8192), 16, 0, 0); } while (0)
#define PG8_LDA(dst, b, h) do { _Pragma("unroll") for (int m = 0; m < 4; ++m) _Pragma("unroll") for (int k = 0; k < 2; ++k) dst[m][k] = *(const LAS bf16x8*)(lds + PG8_SA(b, h) + aoff + m * 2048 + k * 1024); } while (0)
#define PG8_LDB(dst, b, h) do { _Pragma("unroll") for (int n = 0; n < 2; ++n) _Pragma("unroll") for (int k = 0; k < 2; ++k) dst[n][k] = *(const LAS bf16x8*)(lds + PG8_SB(b, h) + boff + n * 2048 + k * 1024); } while (0)
#define PG8_MMA(ai, bj, At, Bt) do { __builtin_amdgcn_s_setprio(1); _Pragma("unroll") for (int m = 0; m < 4; ++m) _Pragma("unroll") for (int n = 0; n < 2; ++n) _Pragma("unroll") for (int k = 0; k < 2; ++k) \
        acc[ai][bj][m][n] = __builtin_amdgcn_mfma_f32_16x16x32_bf16(Bt[n][k], At[m][k], acc[ai][bj][m][n], 0, 0, 0); __builtin_amdgcn_s_setprio(0); } while (0)
#define PG8_WAIT_V(n) asm volatile("s_waitcnt vmcnt(" #n ")" ::: "memory")
#define PG8_WAIT_L(n) asm volatile("s_waitcnt lgkmcnt(" #n ")" ::: "memory")
#define PG8_BAR __builtin_amdgcn_s_barrier()
#define PG8_SCHED __builtin_amdgcn_sched_barrier(0)
    Unit cur, nxt; int ui = 0;
    if (!S.next(0, cur)) return;
    f32x4 acc[2][2][4][2];
#pragma unroll
    for (int a = 0; a < 2; ++a)
#pragma unroll
        for (int b = 0; b < 2; ++b)
#pragma unroll
            for (int m = 0; m < 4; ++m)
#pragma unroll
                for (int n = 0; n < 2; ++n) acc[a][b][m][n] = (f32x4){0.f, 0.f, 0.f, 0.f};
    bf16x8 At[4][2], B0[2][2], B1[2][2];
    const char* cA = (const char*)g.A + (size_t)cur.pm * tstepA; const char* cB = (const char*)g.Bt + (size_t)cur.pn * tstepB;
    if constexpr (SP2) {
        PG8_STAGE(PG8_SB(0, 0), cB, voffB); PG8_STAGE(PG8_SB(0, 1), cB + hstepB, voffB); PG8_STAGE(PG8_SA(0, 0), cA, voffA); PG8_STAGE(PG8_SA(0, 1), cA + hstepA, voffA);
        if (wr == 1) PG8_BAR;
        PG8_WAIT_V(2); PG8_BAR;
        PG8_STAGE(PG8_SB(1, 0), cB + kstep, voffB); PG8_STAGE(PG8_SA(1, 0), cA + kstep, voffA); PG8_STAGE(PG8_SB(1, 1), cB + hstepB + kstep, voffB);
        PG8_WAIT_V(6); PG8_BAR;
    } else {
        PG8_STAGE(PG8_SB(0, 0), cB, voffB); PG8_STAGE(PG8_SA(0, 0), cA, voffA); PG8_STAGE(PG8_SB(0, 1), cB + hstepB, voffB); PG8_STAGE(PG8_SA(0, 1), cA + hstepA, voffA);
        if (wr == 1) PG8_BAR;
        PG8_WAIT_V(4); PG8_BAR;
        PG8_STAGE(PG8_SB(1, 0), cB + kstep, voffB); PG8_STAGE(PG8_SA(1, 0), cA + kstep, voffA); PG8_STAGE(PG8_SB(1, 1), cB + hstepB + kstep, voffB);
        PG8_WAIT_V(6); PG8_BAR;
    }
    for (;;) {
        const bool has_next = S.next(ui + 1, nxt);
        const char* nA = has_next ? (const char*)g.A + (size_t)nxt.pm * tstepA : cA; const char* nB = has_next ? (const char*)g.Bt + (size_t)nxt.pn * tstepB : cB;
        for (int t = 0; t < nt; t += 2) {
            const bool last = (t == nt - 2);
            const char* a1 = cA + (size_t)(t + 1) * kstep;
            const char* a2 = last ? nA : cA + (size_t)(t + 2) * kstep; const char* b2 = last ? nB : cB + (size_t)(t + 2) * kstep;
            const char* a3 = a2 + kstep; const char* b3 = b2 + kstep;
            if constexpr (SP2) {
            PG8_LDB(B0, 0, 0); PG8_LDB(B1, 0, 1); PG8_SCHED; PG8_LDA(At, 0, 0); PG8_STAGE(PG8_SA(1, 1), a1 + hstepA, voffA);
            PG8_WAIT_V(8); PG8_WAIT_L(0); PG8_BAR; PG8_MMA(0, 0, At, B0); PG8_MMA(0, 1, At, B1); PG8_BAR; PG8_SCHED;
            PG8_LDA(At, 0, 1); PG8_STAGE(PG8_SB(0, 0), b2, voffB); PG8_STAGE(PG8_SB(0, 1), b2 + hstepB, voffB); PG8_STAGE(PG8_SA(0, 0), a2, voffA);
            PG8_WAIT_V(8); PG8_WAIT_L(0); PG8_BAR; PG8_MMA(1, 0, At, B0); PG8_MMA(1, 1, At, B1); PG8_BAR; PG8_SCHED;
            PG8_LDB(B0, 1, 0); PG8_LDB(B1, 1, 1); PG8_SCHED; PG8_LDA(At, 1, 0); PG8_STAGE(PG8_SA(0, 1), a2 + hstepA, voffA);
            PG8_WAIT_V(8); PG8_WAIT_L(0); PG8_BAR; PG8_MMA(0, 0, At, B0); PG8_MMA(0, 1, At, B1); PG8_BAR; PG8_SCHED;
            PG8_LDA(At, 1, 1); PG8_STAGE(PG8_SB(1, 0), b3, voffB); PG8_STAGE(PG8_SB(1, 1), b3 + hstepB, voffB); PG8_STAGE(PG8_SA(1, 0), a3, voffA);
            PG8_WAIT_V(8); PG8_WAIT_L(0); PG8_BAR; PG8_MMA(1, 0, At, B0); PG8_MMA(1, 1, At, B1); PG8_BAR; PG8_SCHED;
            } else {
            PG8_LDB(B0, 0, 0); PG8_SCHED; PG8_LDA(At, 0, 0); PG8_STAGE(PG8_SA(1, 1), a1 + hstepA, voffA);
            PG8_WAIT_L(8); PG8_BAR; PG8_WAIT_L(0); PG8_MMA(0, 0, At, B0); PG8_BAR; PG8_SCHED;
            PG8_LDB(B1, 0, 1); PG8_STAGE(PG8_SB(0, 0), b2, voffB);
            PG8_BAR; PG8_WAIT_L(0); PG8_MMA(0, 1, At, B1); PG8_BAR;
            PG8_LDA(At, 0, 1); PG8_STAGE(PG8_SA(0, 0), a2, voffA);
            PG8_BAR; PG8_WAIT_L(0); PG8_MMA(1, 0, At, B0); PG8_BAR; PG8_SCHED;
            PG8_STAGE(PG8_SB(0, 1), b2 + hstepB, voffB);
            PG8_WAIT_V(6); PG8_BAR; PG8_MMA(1, 1, At, B1); PG8_BAR;
            PG8_LDB(B0, 1, 0); PG8_SCHED; PG8_LDA(At, 1, 0); PG8_STAGE(PG8_SA(0, 1), a2 + hstepA, voffA);
            PG8_WAIT_L(8); PG8_BAR; PG8_WAIT_L(0); PG8_MMA(0, 0, At, B0); PG8_BAR; PG8_SCHED;
            PG8_LDB(B1, 1, 1); PG8_STAGE(PG8_SB(1, 0), b3, voffB);
            PG8_BAR; PG8_WAIT_L(0); PG8_MMA(0, 1, At, B1); PG8_BAR;
            PG8_LDA(At, 1, 1); PG8_STAGE(PG8_SA(1, 0), a3, voffA);
            PG8_BAR; PG8_WAIT_L(0); PG8_MMA(1, 0, At, B0); PG8_BAR; PG8_SCHED;
            PG8_STAGE(PG8_SB(1, 1), b3 + hstepB, voffB);
            PG8_WAIT_V(6); PG8_BAR; PG8_MMA(1, 1, At, B1); PG8_BAR;
            }
        }
        if constexpr (ALIGN_EPI) { if (wr == 0) PG8_BAR; }
        E(acc, cur, has_next ? nxt.pm : cur.pm, ui, wr, wc, fr, fq);
        if (!has_next) break;
#pragma unroll
        for (int a = 0; a < 2; ++a)
#pragma unroll
            for (int b = 0; b < 2; ++b)
#pragma unroll
                for (int m = 0; m < 4; ++m)
#pragma unroll
                    for (int n = 0; n < 2; ++n) acc[a][b][m][n] = (f32x4){0.f, 0.f, 0.f, 0.f};
        cur = nxt; cA = nA; cB = nB; ++ui;
        if constexpr (ALIGN_EPI) { if (wr == 1) PG8_BAR; }
    }
    PG8_WAIT_V(0);
    if constexpr (!ALIGN_EPI) { if (wr == 0) PG8_BAR; }
    PG8_BAR;
#undef PG8_SA
#undef PG8_SB
#undef PG8_STAGE
#undef PG8_LDA
#undef PG8_LDB
#undef PG8_MMA
#undef PG8_WAIT_V
#undef PG8_WAIT_L
#undef PG8_BAR
#undef PG8_SCHED
}

__device__ __forceinline__ float rstd16(const float* ssq, int r) {
    const f32x4* p = (const f32x4*)(ssq + (size_t)r * 16);
    const f32x4 a = p[0], b = p[1], c = p[2], d = p[3];
    const float s = ((a[0] + a[1]) + (a[2] + a[3])) + ((b[0] + b[1]) + (b[2] + b[3])) + ((c[0] + c[1]) + (c[2] + c[3])) + ((d[0] + d[1]) + (d[2] + d[3]));
    return __builtin_amdgcn_rsqf(s * (1.0f / 1024.0f) + EPS);
}
constexpr int RSL_OFF = 131072 + 64;
template <int MODE> __device__ __forceinline__ const LAS float* tile_rstd_to_lds(LAS unsigned char* lds, int pm, int pm_next, int ui, const float* p, int sel, int tid) {
    LAS float* rsl = (LAS float*)(lds + RSL_OFF);
    if ((ui & 1) == 0) {
        const int half = tid >> 8, rr = tid & 255;
        const int row = (half ? pm_next : pm) * BM + rr;
        rsl[half * 256 + rr] = (MODE == 0) ? rstd16(p, row) : p[(size_t)row * 2 + sel];
        asm volatile("s_waitcnt lgkmcnt(0)" ::: "memory");
        __builtin_amdgcn_s_barrier();
        asm volatile("" ::: "memory");
    }
    return rsl + (ui & 1) * 256;
}
__device__ __forceinline__ float silu_f(float x) { return x * __builtin_amdgcn_rcpf(1.0f + __builtin_amdgcn_exp2f(-1.4426950408889634f * x)); }

struct EpiSwiGLU {
    static constexpr bool PERM = true;
    bf16_t* H; const float* ssq; LAS unsigned char* lds;
    __device__ __forceinline__ void operator()(const f32x4 (&acc)[2][2][4][2], const Unit& u, int pm_next, int ui, int wr, int wc, int fr, int fq) const {
        const int row0 = u.pm * BM + wr * 64 + fr, col0 = u.pn * 128 + wc * 32 + 8 * fq;
        const LAS float* rsl = tile_rstd_to_lds<0>(lds, u.pm, pm_next, ui, ssq, 0, (wr * 4 + wc) * 64 + fq * 16 + fr);
#pragma unroll
        for (int ai = 0; ai < 2; ++ai)
#pragma unroll
            for (int m = 0; m < 4; ++m) {
                const int r = row0 + ai * HALF + m * 16; const float rs = rsl[wr * 64 + fr + ai * HALF + m * 16];
                float hv[8];
#pragma unroll
                for (int n = 0; n < 2; ++n)
#pragma unroll
                    for (int j = 0; j < 4; ++j) hv[n * 4 + j] = silu_f(acc[ai][0][m][n][j] * rs) * (acc[ai][1][m][n][j] * rs);
                u32x4 w; w.x = cvt_pk_bf16(hv[0], hv[1]); w.y = cvt_pk_bf16(hv[2], hv[3]); w.z = cvt_pk_bf16(hv[4], hv[5]); w.w = cvt_pk_bf16(hv[6], hv[7]);
                *(u32x4*)(H + (size_t)r * FF + col0) = w;
            }
    }
};
struct EpiResid {
    static constexpr bool PERM = true;
    float* out; bf16_t* xb; float* ssq; float alpha;
    __device__ __forceinline__ void operator()(const f32x4 (&acc)[2][2][4][2], const Unit& u, int pm_next, int ui, int wr, int wc, int fr, int fq) const {
        const int row0 = u.pm * BM + wr * 64 + fr, col0 = u.pn * BM + wc * 32 + 8 * fq;
        u32x4 bwv[2][4][2];
#pragma unroll
        for (int ai = 0; ai < 2; ++ai)
#pragma unroll
            for (int m = 0; m < 4; ++m)
#pragma unroll
                for (int bj = 0; bj < 2; ++bj) bwv[ai][m][bj] = *(const u32x4*)(xb + (size_t)(row0 + ai * HALF + m * 16) * D + col0 + bj * HALF);
        asm volatile("" ::: "memory");
#pragma unroll
        for (int ai = 0; ai < 2; ++ai)
#pragma unroll
            for (int m = 0; m < 4; ++m) {
                const int r = row0 + ai * HALF + m * 16; const size_t off = (size_t)r * D + col0; float s = 0.f;
#pragma unroll
                for (int bj = 0; bj < 2; ++bj) {
                    const u32x4 bw = bwv[ai][m][bj];
                    const f32x4 a0 = acc[ai][bj][m][0], a1 = acc[ai][bj][m][1];
                    const float o0 = bf_lo(bw.x) + a0[0] * alpha, o1 = bf_hi(bw.x) + a0[1] * alpha, o2 = bf_lo(bw.y) + a0[2] * alpha, o3 = bf_hi(bw.y) + a0[3] * alpha;
                    const float o4 = bf_lo(bw.z) + a1[0] * alpha, o5 = bf_hi(bw.z) + a1[1] * alpha, o6 = bf_lo(bw.w) + a1[2] * alpha, o7 = bf_hi(bw.w) + a1[3] * alpha;
                    u32x4 w; w.x = cvt_pk_bf16(o0, o1); w.y = cvt_pk_bf16(o2, o3); w.z = cvt_pk_bf16(o4, o5); w.w = cvt_pk_bf16(o6, o7);
                    *(u32x4*)(xb + off + bj * HALF) = w;
                    if (out) { *(f32x4*)(out + off + bj * HALF) = (f32x4){o0, o1, o2, o3}; *(f32x4*)(out + off + bj * HALF + 4) = (f32x4){o4, o5, o6, o7}; }
                    const float q0 = bf_lo(w.x), q1 = bf_hi(w.x), q2 = bf_lo(w.y), q3 = bf_hi(w.y), q4 = bf_lo(w.z), q5 = bf_hi(w.z), q6 = bf_lo(w.w), q7 = bf_hi(w.w);
                    s += ((q0 * q0 + q1 * q1) + (q2 * q2 + q3 * q3)) + ((q4 * q4 + q5 * q5) + (q6 * q6 + q7 * q7));
                }
                s += shx(s, 16); s += shx(s, 32);
                if (fq == 0) ssq[(size_t)r * 16 + u.pn * 4 + wc] = s;
            }
    }
};
template <int MODE> struct EpiRowBf16 {
    static constexpr bool PERM = true;
    bf16_t* O; int ldc; const float* rsp; int sel; LAS unsigned char* lds;
    __device__ __forceinline__ void operator()(const f32x4 (&acc)[2][2][4][2], const Unit& u, int pm_next, int ui, int wr, int wc, int fr, int fq) const {
        const int row0 = u.pm * BM + wr * 64 + fr, col0 = u.pn * BM + wc * 32 + 8 * fq;
        const LAS float* rsl = tile_rstd_to_lds<MODE>(lds, u.pm, pm_next, ui, rsp, sel, (wr * 4 + wc) * 64 + fq * 16 + fr);
#pragma unroll
        for (int ai = 0; ai < 2; ++ai)
#pragma unroll
            for (int m = 0; m < 4; ++m) {
                const int r = row0 + ai * HALF + m * 16; const float rs = rsl[wr * 64 + fr + ai * HALF + m * 16];
#pragma unroll
                for (int bj = 0; bj < 2; ++bj) {
                    const f32x4 v0 = acc[ai][bj][m][0] * rs, v1 = acc[ai][bj][m][1] * rs;
                    u32x4 w; w.x = cvt_pk_bf16(v0[0], v0[1]); w.y = cvt_pk_bf16(v0[2], v0[3]); w.z = cvt_pk_bf16(v1[0], v1[1]); w.w = cvt_pk_bf16(v1[2], v1[3]);
                    *(u32x4*)(O + (size_t)r * ldc + col0 + bj * HALF) = w;
                }
            }
    }
};
struct EpiColBf16 {
    static constexpr bool PERM = true;
    bf16_t* O; int ldc; const float* rsd;
    __device__ __forceinline__ void operator()(const f32x4 (&acc)[2][2][4][2], const Unit& u, int pm_next, int ui, int wr, int wc, int fr, int fq) const {
        const int row0 = u.pm * BM + wr * 64 + fr, col0 = u.pn * BM + wc * 32 + 8 * fq;
        float cs[2][8];
#pragma unroll
        for (int bj = 0; bj < 2; ++bj)
#pragma unroll
            for (int j = 0; j < 8; ++j) cs[bj][j] = rsd[(size_t)(col0 + bj * HALF + j) * 2 + 1];
        asm volatile("" ::: "memory");
#pragma unroll
        for (int bj = 0; bj < 2; ++bj)
#pragma unroll
            for (int ai = 0; ai < 2; ++ai)
#pragma unroll
                for (int m = 0; m < 4; ++m) {
                    const int r = row0 + ai * HALF + m * 16;
                    const f32x4 v0 = acc[ai][bj][m][0], v1 = acc[ai][bj][m][1];
                    u32x4 w; w.x = cvt_pk_bf16(v0[0] * cs[bj][0], v0[1] * cs[bj][1]); w.y = cvt_pk_bf16(v0[2] * cs[bj][2], v0[3] * cs[bj][3]);
                    w.z = cvt_pk_bf16(v1[0] * cs[bj][4], v1[1] * cs[bj][5]); w.w = cvt_pk_bf16(v1[2] * cs[bj][6], v1[3] * cs[bj][7]);
                    *(u32x4*)(O + (size_t)r * ldc + col0 + bj * HALF) = w;
                }
    }
};
struct EpiConvIn {
    static constexpr bool PERM = true;
    bf16_t* U; bf16_t* GB; const float* ssq; LAS unsigned char* lds;
    __device__ __forceinline__ void operator()(const f32x4 (&acc)[2][2][4][2], const Unit& u, int pm_next, int ui, int wr, int wc, int fr, int fq) const {
        const int row0 = u.pm * BM + wr * 64 + fr;
        const LAS float* rsl = tile_rstd_to_lds<0>(lds, u.pm, pm_next, ui, ssq, 0, (wr * 4 + wc) * 64 + fq * 16 + fr);
#pragma unroll
        for (int ai = 0; ai < 2; ++ai)
#pragma unroll
            for (int m = 0; m < 4; ++m) {
                const int r = row0 + ai * HALF + m * 16; const float rs = rsl[wr * 64 + fr + ai * HALF + m * 16];
                if (u.pn < 8) {
                    const f32x4 v0 = (acc[ai][0][m][0] * rs) * (acc[ai][1][m][0] * rs), v1 = (acc[ai][0][m][1] * rs) * (acc[ai][1][m][1] * rs);
                    u32x4 w; w.x = cvt_pk_bf16(v0[0], v0[1]); w.y = cvt_pk_bf16(v0[2], v0[3]); w.z = cvt_pk_bf16(v1[0], v1[1]); w.w = cvt_pk_bf16(v1[2], v1[3]);
                    *(u32x4*)(U + (size_t)r * D + u.pn * 128 + wc * 32 + 8 * fq) = w;
                } else {
#pragma unroll
                    for (int bj = 0; bj < 2; ++bj) {
                        const f32x4 v0 = acc[ai][bj][m][0] * rs, v1 = acc[ai][bj][m][1] * rs;
                        u32x4 w; w.x = cvt_pk_bf16(v0[0], v0[1]); w.y = cvt_pk_bf16(v0[2], v0[3]); w.z = cvt_pk_bf16(v1[0], v1[1]); w.w = cvt_pk_bf16(v1[2], v1[3]);
                        *(u32x4*)(GB + (size_t)r * D + (u.pn - 8) * BM + bj * HALF + wc * 32 + 8 * fq) = w;
                    }
                }
            }
    }
};
}

namespace att {
constexpr int KROW = 208, VROW = 144, KBUF = 64 * KROW, VBUF = 64 * VROW;
constexpr int LDS_K0 = 0, LDS_V0 = 3 * KBUF, LDS_SC = LDS_V0 + 2 * VBUF, LDS_TOTAL = LDS_SC + 8 * 32 * 4;
__device__ __forceinline__ int crow(int r, int hi) { return (r & 3) + 8 * (r >> 2) + 4 * hi; }

__device__ __forceinline__ void attn_qk(f32x16& P0, f32x16& P1, const LAS unsigned char* kb, const bf16x8 (&qr)[6]) {
    f32x16 z;
#pragma unroll
    for (int r = 0; r < 16; ++r) z[r] = 0.f;
    bf16x8 kf[12];
#pragma unroll
    for (int d0 = 0; d0 < 6; ++d0) { kf[2 * d0] = *(const LAS bf16x8*)(kb + d0 * 32); kf[2 * d0 + 1] = *(const LAS bf16x8*)(kb + 32 * KROW + d0 * 32); }
    __builtin_amdgcn_sched_barrier(0);
#pragma unroll
    for (int d0 = 0; d0 < 6; ++d0) {
        if (d0 == 0) { P0 = __builtin_amdgcn_mfma_f32_32x32x16_bf16(kf[0], qr[0], z, 0, 0, 0); P1 = __builtin_amdgcn_mfma_f32_32x32x16_bf16(kf[1], qr[0], z, 0, 0, 0); }
        else { P0 = __builtin_amdgcn_mfma_f32_32x32x16_bf16(kf[2 * d0], qr[d0], P0, 0, 0, 0); P1 = __builtin_amdgcn_mfma_f32_32x32x16_bf16(kf[2 * d0 + 1], qr[d0], P1, 0, 0, 0); }
    }
    __builtin_amdgcn_sched_barrier(0);
}
__device__ __forceinline__ void attn_sm_pv(f32x16& P0, f32x16& P1, f32x16& o0, f32x16& o1, float& l_run, const LAS unsigned char* vb, bool diag, int q, int kvb) {
    if (diag) {
#pragma unroll
        for (int r = 0; r < 16; ++r) { const int kv = kvb + (r & 3) + 8 * (r >> 2); if (kv > q) P0[r] = -INFINITY; if (kv + 32 > q) P1[r] = -INFINITY; }
    }
    bf16x8 vfr[8];
#pragma unroll
    for (int s = 0; s < 4; ++s) { vfr[2 * s] = *(const LAS bf16x8*)(vb + s * 32); vfr[2 * s + 1] = *(const LAS bf16x8*)(vb + 32 * VROW + s * 32); }
    __builtin_amdgcn_sched_barrier(0);
    float s0 = 0.f, s1 = 0.f;
#pragma unroll
    for (int r = 0; r < 16; ++r) { P0[r] = __builtin_amdgcn_exp2f(P0[r]); P1[r] = __builtin_amdgcn_exp2f(P1[r]); s0 += P0[r]; s1 += P1[r]; }
    l_run += s0 + s1;
#pragma unroll
    for (int s = 0; s < 4; ++s) {
        u32x4 pw;
        if (s < 2) { const int b = 8 * s; pw.x = cvt_pk_bf16(P0[b], P0[b + 1]); pw.y = cvt_pk_bf16(P0[b + 2], P0[b + 3]); pw.z = cvt_pk_bf16(P0[b + 4], P0[b + 5]); pw.w = cvt_pk_bf16(P0[b + 6], P0[b + 7]); }
        else { const int b = 8 * (s - 2); pw.x = cvt_pk_bf16(P1[b], P1[b + 1]); pw.y = cvt_pk_bf16(P1[b + 2], P1[b + 3]); pw.z = cvt_pk_bf16(P1[b + 4], P1[b + 5]); pw.w = cvt_pk_bf16(P1[b + 6], P1[b + 7]); }
        const bf16x8 pa = __builtin_bit_cast(bf16x8, pw);
        o0 = __builtin_amdgcn_mfma_f32_32x32x16_bf16(pa, vfr[2 * s], o0, 0, 0, 0);
        o1 = __builtin_amdgcn_mfma_f32_32x32x16_bf16(pa, vfr[2 * s + 1], o1, 0, 0, 0);
    }
}

__device__ __forceinline__ void attn_qk_f(f32x16& P0, f32x16& P1, const LAS unsigned char* kb, const bf16x8 (&qr)[6]) {
    bf16x8 kf[12];
#pragma unroll
    for (int d0 = 0; d0 < 6; ++d0) { kf[2 * d0] = *(const LAS bf16x8*)(kb + d0 * 32); kf[2 * d0 + 1] = *(const LAS bf16x8*)(kb + 32 * KROW + d0 * 32); }
    __builtin_amdgcn_sched_barrier(0);
    f32x16 z;
#pragma unroll
    for (int r = 0; r < 16; ++r) z[r] = 0.f;
    __builtin_amdgcn_s_setprio(1);
    P0 = __builtin_amdgcn_mfma_f32_32x32x16_bf16(kf[0], qr[0], z, 0, 0, 0); P1 = __builtin_amdgcn_mfma_f32_32x32x16_bf16(kf[1], qr[0], z, 0, 0, 0);
#pragma unroll
    for (int d0 = 1; d0 < 6; ++d0) { P0 = __builtin_amdgcn_mfma_f32_32x32x16_bf16(kf[2 * d0], qr[d0], P0, 0, 0, 0); P1 = __builtin_amdgcn_mfma_f32_32x32x16_bf16(kf[2 * d0 + 1], qr[d0], P1, 0, 0, 0); }
    __builtin_amdgcn_s_setprio(0);
    __builtin_amdgcn_sched_barrier(0);
}
__device__ __forceinline__ void attn_sm_f(f32x16& P0, f32x16& P1, float& l_run, u32x4 (&pw)[4]) {
    float s0 = 0.f, s1 = 0.f;
#pragma unroll
    for (int r = 0; r < 16; ++r) { P0[r] = __builtin_amdgcn_exp2f(P0[r]); P1[r] = __builtin_amdgcn_exp2f(P1[r]); s0 += P0[r]; s1 += P1[r]; }
    l_run += s0 + s1;
#pragma unroll
    for (int s = 0; s < 2; ++s) { const int b = 8 * s;
        pw[s].x = cvt_pk_bf16(P0[b], P0[b + 1]); pw[s].y = cvt_pk_bf16(P0[b + 2], P0[b + 3]); pw[s].z = cvt_pk_bf16(P0[b + 4], P0[b + 5]); pw[s].w = cvt_pk_bf16(P0[b + 6], P0[b + 7]);
        pw[s + 2].x = cvt_pk_bf16(P1[b], P1[b + 1]); pw[s + 2].y = cvt_pk_bf16(P1[b + 2], P1[b + 3]); pw[s + 2].z = cvt_pk_bf16(P1[b + 4], P1[b + 5]); pw[s + 2].w = cvt_pk_bf16(P1[b + 6], P1[b + 7]); }
}
__device__ __forceinline__ void attn_pv_f(const u32x4 (&pw)[4], f32x16& o0, f32x16& o1, const LAS unsigned char* vb) {
    u32x2 va[4][2], vc[4][2];
#pragma unroll
    for (int s = 0; s < 4; ++s) { va[s][0] = *(const LAS u32x2*)(vb + s * 32); va[s][1] = *(const LAS u32x2*)(vb + s * 32 + 16);
        vc[s][0] = *(const LAS u32x2*)(vb + 32 * VROW + s * 32); vc[s][1] = *(const LAS u32x2*)(vb + 32 * VROW + s * 32 + 16); }
    __builtin_amdgcn_sched_barrier(0);
    __builtin_amdgcn_s_setprio(1);
#pragma unroll
    for (int s = 0; s < 4; ++s) {
        const bf16x8 pa = __builtin_bit_cast(bf16x8, pw[s]);
        o0 = __builtin_amdgcn_mfma_f32_32x32x16_bf16(pa, __builtin_bit_cast(bf16x8, (u32x4){va[s][0].x, va[s][0].y, va[s][1].x, va[s][1].y}), o0, 0, 0, 0);
        o1 = __builtin_amdgcn_mfma_f32_32x32x16_bf16(pa, __builtin_bit_cast(bf16x8, (u32x4){vc[s][0].x, vc[s][0].y, vc[s][1].x, vc[s][1].y}), o1, 0, 0, 0);
    }
    __builtin_amdgcn_s_setprio(0);
    __builtin_amdgcn_sched_barrier(0);
}

typedef float f32x2_t __attribute__((ext_vector_type(2))); typedef __bf16 bf16x2_t __attribute__((ext_vector_type(2)));
__device__ __forceinline__ unsigned cvtpk_s(float lo, float hi) { f32x2_t v = {lo, hi}; bf16x2_t b = __builtin_convertvector(v, bf16x2_t); return __builtin_bit_cast(unsigned, b); }
struct Stage3 { u32x4 k0, k1, v; };
template <int VAR> __device__ __forceinline__ Stage3 attn_full_step(f32x16& PA0, f32x16& PA1, f32x16& PB0, f32x16& PB1, f32x16& o0, f32x16& o1, float& l_run,
                                               const LAS unsigned char* kb, const LAS unsigned char* vb, const bf16x8 (&qr)[6],
                                               u32x4 kg0, u32x4 kg1, u32x4 vg, LAS unsigned char* kst0, LAS unsigned char* kst1, LAS unsigned char* vst, bool k1v,
                                               const char* kn0, const char* kn1, const bf16_t* vn) {
    bf16x8 kf[12], vf[8];
#pragma unroll
    for (int d0 = 0; d0 < 6; ++d0) { kf[2 * d0] = *(const LAS bf16x8*)(kb + d0 * 32); kf[2 * d0 + 1] = *(const LAS bf16x8*)(kb + 32 * KROW + d0 * 32); }
    __builtin_amdgcn_sched_barrier(0);
    f32x16 z;
#pragma unroll
    for (int r = 0; r < 16; ++r) z[r] = 0.f;
    __builtin_amdgcn_s_setprio(1);
    PB0 = __builtin_amdgcn_mfma_f32_32x32x16_bf16(kf[0], qr[0], z, 0, 0, 0); PB1 = __builtin_amdgcn_mfma_f32_32x32x16_bf16(kf[1], qr[0], z, 0, 0, 0);
#pragma unroll
    for (int d0 = 1; d0 < 6; ++d0) { PB0 = __builtin_amdgcn_mfma_f32_32x32x16_bf16(kf[2 * d0], qr[d0], PB0, 0, 0, 0); PB1 = __builtin_amdgcn_mfma_f32_32x32x16_bf16(kf[2 * d0 + 1], qr[d0], PB1, 0, 0, 0); }
    __builtin_amdgcn_s_setprio(0);
    __builtin_amdgcn_sched_barrier(0);
    if constexpr (!(VAR & 2)) {
        *(LAS u32x4*)kst0 = kg0; if (k1v) *(LAS u32x4*)kst1 = kg1;
        *(LAS u32x2*)vst = (u32x2){vg.x, vg.y}; *(LAS u32x2*)(vst + 16) = (u32x2){vg.z, vg.w};
        kg0 = *(const u32x4*)kn0; if (k1v) kg1 = *(const u32x4*)kn1;
        vg = *(const u32x4*)vn;
    }
#pragma unroll
    for (int s = 0; s < 4; ++s) { vf[2 * s] = *(const LAS bf16x8*)(vb + s * 32); vf[2 * s + 1] = *(const LAS bf16x8*)(vb + 32 * VROW + s * 32); }
    __builtin_amdgcn_sched_barrier(0);
    float s0 = 0.f, s1 = 0.f;
#pragma unroll
    for (int r = 0; r < 16; ++r) { PA0[r] = __builtin_amdgcn_exp2f(PA0[r]); PA1[r] = __builtin_amdgcn_exp2f(PA1[r]); s0 += PA0[r]; s1 += PA1[r]; }
    l_run += s0 + s1;
    u32x4 pw[4];
#pragma unroll
    for (int s = 0; s < 2; ++s) { const int b = 8 * s;
        pw[s].x = cvtpk_s(PA0[b], PA0[b + 1]); pw[s].y = cvtpk_s(PA0[b + 2], PA0[b + 3]); pw[s].z = cvtpk_s(PA0[b + 4], PA0[b + 5]); pw[s].w = cvtpk_s(PA0[b + 6], PA0[b + 7]);
        pw[s + 2].x = cvtpk_s(PA1[b], PA1[b + 1]); pw[s + 2].y = cvtpk_s(PA1[b + 2], PA1[b + 3]); pw[s + 2].z = cvtpk_s(PA1[b + 4], PA1[b + 5]); pw[s + 2].w = cvtpk_s(PA1[b + 6], PA1[b + 7]); }
    __builtin_amdgcn_sched_barrier(0);
    __builtin_amdgcn_s_setprio(1);
#pragma unroll
    for (int s = 0; s < 4; ++s) {
        const bf16x8 pa = __builtin_bit_cast(bf16x8, pw[s]);
        o0 = __builtin_amdgcn_mfma_f32_32x32x16_bf16(pa, vf[2 * s], o0, 0, 0, 0);
        o1 = __builtin_amdgcn_mfma_f32_32x32x16_bf16(pa, vf[2 * s + 1], o1, 0, 0, 0);
    }
    __builtin_amdgcn_s_setprio(0);
    __builtin_amdgcn_sched_barrier(0);
    Stage3 r_; r_.k0 = kg0; r_.k1 = kg1; r_.v = vg; return r_;
}

template <int VAR> __device__ __forceinline__ void attn_unit(int h, int qb, const bf16_t* Q, const bf16_t* K, const bf16_t* Vt, bf16_t* AO, LAS unsigned char* lds) {
    const int wid = wave_index(lds); int tid_ = wid * 64 + lane_id(); asm volatile("" : "+v"(tid_));
    const int tid = tid_, lane = tid & 63, r32 = lane & 31, hi = lane >> 5;
    const int q0w = qb * 256 + wid * 32, NT = 4 * qb + 4;
    const int tlast = (q0w + 31) >> 6;
    const char* Kh = (const char*)(K + (size_t)h * S * DQK);
    const bf16_t* Vh = Vt + (size_t)h * DV * S;
    bf16x8 qr[6];
    { const bf16_t* qp = Q + ((size_t)h * S + q0w + r32) * DQK + hi * 8;
#pragma unroll
      for (int d0 = 0; d0 < 6; ++d0) qr[d0] = *(const bf16x8*)(qp + d0 * 16); }
    const int c0 = tid, c1 = tid + 512;
    const int k0dst = (c0 / 12) * KROW + (c0 % 12) * 16, k1dst = (c1 / 12) * KROW + (c1 % 12) * 16;
    const int vrow = tid >> 3, vc8 = tid & 7, vdst = vrow * VROW + (vc8 >> 1) * 32 + (vc8 & 1) * 8;
    const bf16_t* vsrc = Vh + (size_t)vrow * S + vc8 * 8;
    const bool k1v = tid < 256;
    LAS float* sc = (LAS float*)(lds + LDS_SC) + wid * 32;
    const LAS unsigned char* kfrag = lds + LDS_K0 + r32 * KROW + hi * 16;
    const LAS unsigned char* vfrag = lds + LDS_V0 + r32 * VROW + hi * 16;
    const int q = q0w + r32;
    float l_run = 0.f;
    f32x16 o0, o1, pA0, pA1, pB0, pB1;
#pragma unroll
    for (int r = 0; r < 16; ++r) { o0[r] = 0.f; o1[r] = 0.f; pA0[r] = 0.f; pA1[r] = 0.f; pB0[r] = 0.f; pB1[r] = 0.f; }
#define ATT_KST(slot, g0, g1) do { *(LAS u32x4*)(lds + LDS_K0 + (slot) * KBUF + k0dst) = (g0); if (k1v) *(LAS u32x4*)(lds + LDS_K0 + (slot) * KBUF + k1dst) = (g1); } while (0)
#define ATT_VST(slot, g) do { *(LAS u32x2*)(lds + LDS_V0 + (slot) * VBUF + vdst) = (u32x2){(g).x, (g).y}; *(LAS u32x2*)(lds + LDS_V0 + (slot) * VBUF + vdst + 16) = (u32x2){(g).z, (g).w}; } while (0)
    u32x4 kg0, kg1 = (u32x4){0u, 0u, 0u, 0u}, vg;
    {
        const u32x4 z4 = (u32x4){0u, 0u, 0u, 0u};
        const u32x4 a = *(const u32x4*)(Kh + c0 * 16); const u32x4 b = k1v ? *(const u32x4*)(Kh + c1 * 16) : z4;
        const u32x4 a2 = *(const u32x4*)(Kh + 64 * DQK * 2 + c0 * 16); const u32x4 b2 = k1v ? *(const u32x4*)(Kh + 64 * DQK * 2 + c1 * 16) : z4;
        const u32x4 v = *(const u32x4*)(vsrc);
        kg0 = *(const u32x4*)(Kh + 2 * 64 * DQK * 2 + c0 * 16); if (k1v) kg1 = *(const u32x4*)(Kh + 2 * 64 * DQK * 2 + c1 * 16);
        vg = *(const u32x4*)(vsrc + 64);
        ATT_KST(0, a, b); ATT_KST(1, a2, b2); ATT_VST(0, v);
    }
    __syncthreads();
    attn_qk(pA0, pA1, kfrag, qr);
    int k1 = 1, k2 = 2;
#define ATT_STEP(PA0, PA1, PB0, PB1, t) do { \
        if ((t) + 2 < NT) ATT_KST(k2, kg0, kg1); \
        if ((t) + 1 < NT) ATT_VST(((t) + 1) & 1, vg); \
        if ((t) + 3 < NT) { const char* kt = Kh + (size_t)((t) + 3) * 64 * DQK * 2; kg0 = *(const u32x4*)(kt + c0 * 16); if (k1v) kg1 = *(const u32x4*)(kt + c1 * 16); } \
        if ((t) + 2 < NT) vg = *(const u32x4*)(vsrc + (size_t)((t) + 2) * 64); \
        if ((t) + 1 <= tlast) attn_qk(PB0, PB1, kfrag + k1 * KBUF, qr); \
        if ((t) <= tlast) attn_sm_pv(PA0, PA1, o0, o1, l_run, vfrag + ((t) & 1) * VBUF, 64 * (t) + 63 > q0w, q, 64 * (t) + 4 * hi); \
        __syncthreads(); \
        k1 = k2; k2 = (k2 == 2) ? 0 : k2 + 1; \
    } while (0)
#define ATT_FULL(PA0, PA1, PB0, PB1, t) do { \
        bf16x8 vf[8]; u32x4 pw[4]; f32x16 z_; \
        _Pragma("unroll") for (int r = 0; r < 16; ++r) z_[r] = 0.f; \
        float s0_ = 0.f, s1_ = 0.f; \
        _Pragma("unroll") for (int g = 0; g < 12; ++g) {        \
            if (g & 1) PB1 = __builtin_amdgcn_mfma_f32_32x32x16_bf16(kf[g], qr[g >> 1], (g == 1) ? z_ : PB1, 0, 0, 0); \
            else       PB0 = __builtin_amdgcn_mfma_f32_32x32x16_bf16(kf[g], qr[g >> 1], (g == 0) ? z_ : PB0, 0, 0, 0); \
            _Pragma("unroll") for (int e = (32 * g) / 12; e < (32 * (g + 1)) / 12; ++e) { \
                if (e < 16) { PA0[e] = __builtin_amdgcn_exp2f(PA0[e]); s0_ += PA0[e]; } else { PA1[e - 16] = __builtin_amdgcn_exp2f(PA1[e - 16]); s1_ += PA1[e - 16]; } } \
            __builtin_amdgcn_sched_barrier(0); \
        } \
        ATT_KST(k2, kg0, kg1); ATT_VST(((t) + 1) & 1, vg); \
        { const char* kt_ = Kh + (size_t)((t) + 3) * 64 * DQK * 2; kg0 = *(const u32x4*)(kt_ + c0 * 16); if (k1v) kg1 = *(const u32x4*)(kt_ + c1 * 16); } \
        vg = *(const u32x4*)(vsrc + (size_t)((t) + 2) * 64); \
        { const LAS unsigned char* vb_ = vfrag + ((t) & 1) * VBUF; \
          _Pragma("unroll") for (int s = 0; s < 4; ++s) { vf[2 * s] = *(const LAS bf16x8*)(vb_ + s * 32); vf[2 * s + 1] = *(const LAS bf16x8*)(vb_ + 32 * VROW + s * 32); } } \
        __builtin_amdgcn_sched_barrier(0); \
        l_run += s0_ + s1_; \
        _Pragma("unroll") for (int s = 0; s < 2; ++s) { const int b = 8 * s; \
            pw[s].x = cvtpk_s(PA0[b], PA0[b + 1]); pw[s].y = cvtpk_s(PA0[b + 2], PA0[b + 3]); pw[s].z = cvtpk_s(PA0[b + 4], PA0[b + 5]); pw[s].w = cvtpk_s(PA0[b + 6], PA0[b + 7]); \
            pw[s + 2].x = cvtpk_s(PA1[b], PA1[b + 1]); pw[s + 2].y = cvtpk_s(PA1[b + 2], PA1[b + 3]); pw[s + 2].z = cvtpk_s(PA1[b + 4], PA1[b + 5]); pw[s + 2].w = cvtpk_s(PA1[b + 6], PA1[b + 7]); } \
        __builtin_amdgcn_sched_barrier(0); \
        __syncthreads(); \
        __builtin_amdgcn_sched_barrier(0); \
        __builtin_amdgcn_s_setprio(1); \
        _Pragma("unroll") for (int s = 0; s < 4; ++s) { const bf16x8 pa_ = __builtin_bit_cast(bf16x8, pw[s]); \
            o0 = __builtin_amdgcn_mfma_f32_32x32x16_bf16(pa_, vf[2 * s], o0, 0, 0, 0); o1 = __builtin_amdgcn_mfma_f32_32x32x16_bf16(pa_, vf[2 * s + 1], o1, 0, 0, 0); } \
        __builtin_amdgcn_s_setprio(0); \
        { const LAS unsigned char* kb_ = kfrag + k2 * KBUF; \
          _Pragma("unroll") for (int d0 = 0; d0 < 6; ++d0) { kf[2 * d0] = *(const LAS bf16x8*)(kb_ + d0 * 32); kf[2 * d0 + 1] = *(const LAS bf16x8*)(kb_ + 32 * KROW + d0 * 32); } } \
        __builtin_amdgcn_sched_barrier(0); \
        k1 = k2; k2 = (k2 == 2) ? 0 : k2 + 1; \
    } while (0)
    int t = 0;
    bf16x8 kf[12];
    if (qb > 0) {
#pragma unroll
        for (int d0 = 0; d0 < 6; ++d0) { kf[2 * d0] = *(const LAS bf16x8*)(kfrag + KBUF + d0 * 32); kf[2 * d0 + 1] = *(const LAS bf16x8*)(kfrag + KBUF + 32 * KROW + d0 * 32); }
    }
    for (; t < 4 * qb; t += 2) {
        ATT_FULL(pA0, pA1, pB0, pB1, t);
        ATT_FULL(pB0, pB1, pA0, pA1, t + 1);
    }
    for (; t < NT; t += 2) {
        ATT_STEP(pA0, pA1, pB0, pB1, t);
        ATT_STEP(pB0, pB1, pA0, pA1, t + 1);
    }
#undef ATT_FULL
#undef ATT_STEP
#undef ATT_KST
#undef ATT_VST
    l_run += shx(l_run, 32);
    if (hi == 0) sc[r32] = __builtin_amdgcn_rcpf(l_run);
    bf16_t* ob = AO + (size_t)q0w * D + 512 + h * DV + r32;
#pragma unroll
    for (int gq = 0; gq < 4; ++gq) { const f32x4 av = *(const LAS f32x4*)(sc + 8 * gq + 4 * hi);
#pragma unroll
        for (int j = 0; j < 4; ++j) { const int r = 4 * gq + j; const int qrow = crow(r, hi);
            ob[(size_t)qrow * D] = f2bf(o0[r] * av[j]); ob[(size_t)qrow * D + 32] = f2bf(o1[r] * av[j]); } }
    __syncthreads();
}
}

constexpr size_t MiB = 1u << 20;
constexpr size_t WS_SSQ = 0;
constexpr size_t WS_RS = 1 * MiB;
constexpr size_t WS_CTL = 1 * MiB + 512 * 1024, CTL_BYTES = 16384;
constexpr int MISC_OFF = 131072 + 32;
constexpr size_t WS_W = 2 * MiB;
constexpr size_t W_FFN_LAYER = 33 * MiB;
constexpr size_t W_GU_BYTES = 11 * MiB, W_DN_BYTES = (size_t)D * FF * 2;
constexpr size_t WS_WEVEN = WS_W + 4 * W_FFN_LAYER;
constexpr size_t WE_IN = 0, WE_Q = (size_t)ZW * D * 2, WE_K = WE_Q + (size_t)768 * 384 * 2, WE_V = WE_K + (size_t)512 * 256 * 2, WE_OUT = WE_V + (size_t)512 * 256 * 2, WE_STRIDE = 6 * MiB;
static_assert(WE_OUT + (size_t)D * D * 2 <= WE_STRIDE, "even-layer weight map");
constexpr size_t WS_WODD = WS_WEVEN + 2 * WE_STRIDE;
constexpr size_t WO_IN = 0, WO_OUT = 6 * MiB, WO_STRIDE = 8 * MiB;
constexpr size_t WS_XB = WS_WODD + 2 * WO_STRIDE;
constexpr size_t WS_ACT = WS_XB + 32 * MiB;
constexpr size_t WS_H = WS_ACT;
constexpr size_t WS_Z = WS_ACT;
constexpr size_t WS_QP = WS_Z + 40 * MiB;
constexpr size_t WS_KP = WS_QP + 24 * MiB;
constexpr size_t WS_VT = WS_KP + 16 * MiB;
constexpr size_t WS_K = WS_VT + 16 * MiB;
constexpr size_t WS_AO = WS_K + 24 * MiB;
constexpr size_t WS_U = WS_ACT, WS_GB = WS_ACT + 32 * MiB;
constexpr size_t WS_Q = WS_AO + 32 * MiB;
constexpr size_t WS_END = WS_Q + 24 * MiB;

constexpr int LDS_BYTES = 131072 + 4096;

struct Args {
    const float* in[23]; float* out; unsigned char* ws;
};


#define XB_TMO      128
#define XB_XCNT(j)  (256  + 64 * (j))
#define XB_XSUB(j)  (1280 + 64 * (j))
#define XB_XGEN(j)  (2304 + 64 * (j))
#define XB_TOP      3328
#define XB_TOPGEN   3392
#define XCD_BAR_WORDS 3456
#define XB_SPIN_CAP (1u << 20)
__device__ __forceinline__ unsigned xb_ld(unsigned* p)              { return __hip_atomic_load(p, __ATOMIC_RELAXED, __HIP_MEMORY_SCOPE_AGENT); }
__device__ __forceinline__ unsigned xb_add(unsigned* p, unsigned v) { return __hip_atomic_fetch_add(p, v, __ATOMIC_RELAXED, __HIP_MEMORY_SCOPE_AGENT); }
__device__ __forceinline__ unsigned xb_xcc_id() { return (unsigned)__builtin_amdgcn_s_getreg((3 << 11) | 20) & 0xFu; }
#define XB_SPIN(cond, bar) do { unsigned _sp = 0; while (cond) { __builtin_amdgcn_s_sleep(1); \
    if ((++_sp & 255u) == 0u) { if (xb_ld(&(bar)[XB_TMO])) break; if (_sp > XB_SPIN_CAP) { atomicAdd(&(bar)[XB_TMO], 1u); break; } } } } while (0)
struct XcdBarrier { unsigned* bar; unsigned x; volatile LAS unsigned* st; };
__device__ __forceinline__ XcdBarrier xcd_barrier_post(unsigned* bar, volatile LAS unsigned* st, bool t0) {
    XcdBarrier b; b.bar = bar; b.x = xb_xcc_id(); b.st = st;
    if (t0) (void)xb_add(&bar[XB_XCNT(b.x)], 1u);
    return b;
}
__device__ __forceinline__ void xcd_barrier_complete(unsigned* bar, unsigned x, unsigned& nloc, unsigned& nx) {
    const unsigned G = gridDim.x * gridDim.y * gridDim.z;
    unsigned sum, cnt, mine, sp = 0u;
    for (;;) {
        sum = 0u; cnt = 0u; mine = 0u;
#pragma unroll
        for (unsigned j = 0; j < 16; ++j) { const unsigned c = xb_ld(&bar[XB_XCNT(j)]); sum += c; cnt += (c > 0u) ? 1u : 0u; mine = (j == x) ? c : mine; }
        if (sum == G) break;
        __builtin_amdgcn_s_sleep(1);
        if ((++sp & 255u) == 0u) { if (xb_ld(&bar[XB_TMO])) break; if (sp > XB_SPIN_CAP) { atomicAdd(&bar[XB_TMO], 1u); break; } }
    }
    nloc = mine > 0u ? mine : 1u; nx = cnt > 0u ? cnt : 1u;
}
__device__ __forceinline__ void xcd_barrier(const XcdBarrier& b, bool t0) {
    asm volatile("s_waitcnt vmcnt(0)" ::: "memory");
    __syncthreads();
    if (t0) {
        unsigned* bar = b.bar;
        __builtin_amdgcn_s_waitcnt(0);
        unsigned nloc = b.st[0], nx = b.st[1];
        if (nloc == 0u) { xcd_barrier_complete(bar, b.x, nloc, nx); b.st[0] = nloc; b.st[1] = nx; }
        const unsigned old = xb_add(&bar[XB_XSUB(b.x)], 1u);
        const unsigned gen = old / nloc;
        if (old + 1u == (gen + 1u) * nloc) {
            __builtin_amdgcn_fence(__ATOMIC_RELEASE, "agent");
            asm volatile("s_waitcnt vmcnt(0)" ::: "memory");
            const unsigned og = xb_add(&bar[XB_TOP], 1u);
            const unsigned tg = og / nx;
            if (og + 1u == (tg + 1u) * nx) xb_add(&bar[XB_TOPGEN], 1u);
            else XB_SPIN(xb_ld(&bar[XB_TOPGEN]) == tg, bar);
            __builtin_amdgcn_fence(__ATOMIC_ACQUIRE, "agent");
            asm volatile("s_waitcnt vmcnt(0)" ::: "memory");
        } else {
            XB_SPIN(xb_ld(&bar[XB_TOPGEN]) == gen, bar);
            __builtin_amdgcn_fence(__ATOMIC_ACQUIRE, "agent");
            asm volatile("s_waitcnt vmcnt(0)" ::: "memory");
        }
    }
    __syncthreads();
}
#ifndef PROBE_PRO_REPS
#define PROBE_PRO_REPS 1
#endif
#ifndef PROBE_EWA_REPS
#define PROBE_EWA_REPS 1
#endif
#ifndef PROBE_EWB_REPS
#define PROBE_EWB_REPS 1
#endif
#ifndef PROBE_EWC_REPS
#define PROBE_EWC_REPS 1
#endif
#ifndef PROBE_GU_REPS
#define PROBE_GU_REPS 1
#endif
#ifndef PROBE_MIXA_REPS
#define PROBE_MIXA_REPS 1
#endif
#ifndef PROBE_MIXB_REPS
#define PROBE_MIXB_REPS 1
#endif
#ifndef PROBE_MIXC_REPS
#define PROBE_MIXC_REPS 1
#endif
#ifndef PROBE_SYNC_REPS
#define PROBE_SYNC_REPS 1
#endif
#define GSYNC() do { for (int r_ = 0; r_ < PROBE_SYNC_REPS; ++r_) { XcdBarrier xb_; xb_.bar = (unsigned*)(KARGS()->ws + WS_CTL); xb_.x = xb_xcc_id(); xb_.st = (volatile LAS unsigned*)(lds + MISC_OFF); xcd_barrier(xb_, wave_index(lds) == 0 && lane_id() == 0); } } while (0)
typedef const __attribute__((address_space(4))) Args* KArgP;
#define KARGS() ({ KArgP p_ = (KArgP)__builtin_amdgcn_kernarg_segment_ptr(); asm volatile("" : "+s"(p_)); p_; })
__device__ __forceinline__ void transpose_item(const float* W, int N, int k0, int n0, const float* g, bf16_t* WT, int ldk, int dst_row, LAS float* scr, int lane) {
    float v[32];
    const float* wp = W + (size_t)(k0 + (lane >> 5)) * N + n0 + (lane & 31);
#pragma unroll
    for (int i = 0; i < 32; ++i) v[i] = wp[(size_t)(2 * i) * N];
    if (g) {
        const float* gp = g + k0 + (lane >> 5);
#pragma unroll
        for (int i = 0; i < 32; ++i) v[i] *= gp[2 * i];
    }
#pragma unroll
    for (int i = 0; i < 32; ++i) scr[(2 * i + (lane >> 5)) * 33 + (lane & 31)] = v[i];
    asm volatile("s_waitcnt lgkmcnt(0)" ::: "memory");
    const int c = lane & 7;
#pragma unroll
    for (int j = 0; j < 4; ++j) { const int n = (lane >> 3) + 8 * j; const LAS float* s = scr + (8 * c) * 33 + n;
        u32x4 o; o.x = cvt_pk_bf16(s[0 * 33], s[1 * 33]); o.y = cvt_pk_bf16(s[2 * 33], s[3 * 33]); o.z = cvt_pk_bf16(s[4 * 33], s[5 * 33]); o.w = cvt_pk_bf16(s[6 * 33], s[7 * 33]);
        *(u32x4*)(WT + (size_t)(dst_row + n) * ldk + k0 + 8 * c) = o; }
    asm volatile("s_waitcnt lgkmcnt(0)" ::: "memory");
}
__device__ __forceinline__ float wave_sum(float v) {
#pragma unroll
    for (int o = 1; o < 64; o <<= 1) v += shx(v, o);
    return v;
}

constexpr int I_FFN_M = 1408, I_FFN = 3 * I_FFN_M, I_LAYER = 2 * I_FFN, I_ALLFFN = 4 * I_LAYER;
constexpr int I_EIN = 16 * 37, I_EQ = 6 * 24, I_EKV = 4 * 32, I_EOUT = 8 * 32, I_EVEN = I_EIN + I_EQ + I_EKV + I_EOUT;
constexpr int I_OIN = 16 * 96, I_OOUT = 16 * 32, I_ODD = I_OIN + I_OOUT;
__device__ __forceinline__ void convert_items(KArgP ap, LAS unsigned char* lds, int lo, int hi, int w, int nw, int wave, int lane) {
    unsigned char* ws = ap->ws;
    LAS float* scr = (LAS float*)(lds + wave * 16384);
    for (int it = lo + w; it < hi; it += nw) {
        int r = it;
        if (r < I_ALLFFN) {
            const int L = r / I_LAYER; r %= I_LAYER; const int f = r / I_FFN; r %= I_FFN; const int mtx = r / I_FFN_M; r %= I_FFN_M;
            bf16_t* wgu = (bf16_t*)(ws + WS_W + L * W_FFN_LAYER + f * (W_GU_BYTES + W_DN_BYTES)); bf16_t* wdn = (bf16_t*)((unsigned char*)wgu + W_GU_BYTES);
            const float* g = ap->in[f == 0 ? 1 : 6] + (size_t)L * D;
            if (mtx < 2) {
                const float* W = ap->in[(f == 0 ? 2 : 7) + mtx] + (size_t)L * D * FF;
                const int kb = r / 88, nb = r % 88, n0 = 32 * nb;
                transpose_item(W, FF, 64 * kb, n0, g, wgu, D, 256 * (n0 / 128) + (n0 % 128) + 128 * mtx, scr, lane);
            } else {
                const float* W = ap->in[f == 0 ? 4 : 9] + (size_t)L * FF * D;
                const int kb = r / 32, nb = r % 32;
                transpose_item(W, D, 64 * kb, 32 * nb, nullptr, wdn, FF, 32 * nb, scr, lane);
            }
            continue;
        }
        r -= I_ALLFFN;
        if (r < 2 * I_EVEN) {
            const int i = r / I_EVEN; r %= I_EVEN; const int L = 2 * i;
            unsigned char* wb = ws + WS_WEVEN + i * WE_STRIDE;
            if (r < I_EIN) { const int kb = r / 37, nb = r % 37;
                transpose_item(ap->in[10] + (size_t)i * D * 1184, 1184, 64 * kb, 32 * nb, ap->in[5] + (size_t)L * D, (bf16_t*)(wb + WE_IN), D, 32 * nb, scr, lane); continue; }
            r -= I_EIN;
            if (r < I_EQ) { const int kb = r / 24, nb = r % 24;
                transpose_item(ap->in[12] + (size_t)i * 384 * 768, 768, 64 * kb, 32 * nb, ap->in[11] + (size_t)i * 384, (bf16_t*)(wb + WE_Q), 384, 32 * nb, scr, lane); continue; }
            r -= I_EQ;
            if (r < I_EKV) { const int kb = r / 32, nb = r % 32, n0 = 32 * nb, hh = n0 / 128, w = n0 % 128;
                bf16_t* dst = (bf16_t*)(wb + (w < 64 ? WE_K : WE_V));
                transpose_item(ap->in[14] + (size_t)i * 256 * 1024, 1024, 64 * kb, n0, ap->in[13] + (size_t)i * 256, dst, 256, hh * 64 + (w & 63), scr, lane); continue; }
            r -= I_EKV;
            { const int kb = r / 32, nb = r % 32;
              transpose_item(ap->in[19] + (size_t)i * D * D, D, 512 + 64 * kb, 32 * nb, nullptr, (bf16_t*)(wb + WE_OUT), D, 32 * nb, scr, lane); }
            continue;
        }
        r -= 2 * I_EVEN;
        {
            const int i = r / I_ODD; r %= I_ODD; const int L = 2 * i + 1;
            unsigned char* wb = ws + WS_WODD + i * WO_STRIDE;
            if (r < I_OIN) { const int kb = r / 96, nb = r % 96, n0 = 32 * nb, seg = n0 / 1024, j = n0 % 1024;
                const int drow = (seg == 0) ? 2048 + j : 256 * (j / 128) + (j % 128) + (seg == 2 ? 128 : 0);
                transpose_item(ap->in[20] + (size_t)i * D * 3072, 3072, 64 * kb, n0, ap->in[5] + (size_t)L * D, (bf16_t*)(wb + WO_IN), D, drow, scr, lane); continue; }
            r -= I_OIN;
            { const int kb = r / 32, nb = r % 32;
              transpose_item(ap->in[22] + (size_t)i * D * D, D, 64 * kb, 32 * nb, nullptr, (bf16_t*)(wb + WO_OUT), D, 32 * nb, scr, lane); }
        }
    }
}
__device__ __forceinline__ void fold_jobs(KArgP ap, LAS unsigned char* lds, int i, int w, int nw, int wave, int lane) {
    unsigned char* ws = ap->ws;
    LAS float* scr = (LAS float*)(lds + wave * 16384);
    {
        const int gt = w * 64 + lane, ngt = nw * 64;
        for (int job = w; job < 1024; job += nw) {
            const int gg = (job >> 8) & 3, kch = (job >> 4) & 15, nb = job & 15, n = nb * 64 + lane;
            const float* wp = ap->in[17] + (size_t)i * 4 * 128 * 128 + ((size_t)gg * 128 + kch * 8) * 128;
            const float* sc = ap->in[18] + (size_t)i * 512 + gg * 128;
            const float* wo = ap->in[19] + (size_t)i * D * D + (size_t)gg * 128 * D + n;
            {
                f32x4 pv[4], sv[4];
#pragma unroll
                for (int q = 0; q < 4; ++q) { const int idx = (q * 64 + lane) * 4; pv[q] = *(const f32x4*)(wp + idx); sv[q] = *(const f32x4*)(sc + (idx & 127)); }
#pragma unroll
                for (int q = 0; q < 4; ++q) *(LAS f32x4*)(scr + (q * 64 + lane) * 4) = pv[q] * sv[q];
            }
            asm volatile("s_waitcnt lgkmcnt(0)" ::: "memory");
            float acc[8];
#pragma unroll
            for (int j = 0; j < 8; ++j) acc[j] = 0.f;
#pragma unroll 1
            for (int c0 = 0; c0 < 128; c0 += 16) {
                float wv[16];
#pragma unroll
                for (int ii = 0; ii < 16; ++ii) wv[ii] = wo[(size_t)(c0 + ii) * D];
                asm volatile("" ::: "memory");
#pragma unroll
                for (int ii = 0; ii < 16; ii += 4)
#pragma unroll
                    for (int j = 0; j < 8; ++j) { const f32x4 wq = *(const LAS f32x4*)(scr + j * 128 + c0 + ii);
                        acc[j] += (wq[0] * wv[ii] + wq[1] * wv[ii + 1]) + (wq[2] * wv[ii + 2] + wq[3] * wv[ii + 3]); }
            }
            u32x4 o; o.x = cvt_pk_bf16(acc[0], acc[1]); o.y = cvt_pk_bf16(acc[2], acc[3]); o.z = cvt_pk_bf16(acc[4], acc[5]); o.w = cvt_pk_bf16(acc[6], acc[7]);
            *(u32x4*)((bf16_t*)(ws + WS_WEVEN + i * WE_STRIDE + WE_OUT) + (size_t)n * D + gg * 128 + kch * 8) = o;
            asm volatile("s_waitcnt lgkmcnt(0)" ::: "memory");
        }
        unsigned zv = 0u; asm volatile("" : "+v"(zv));
        for (int idx = gt; idx < 96 * 128; idx += ngt)
            ((u32x4*)(ws + WS_WEVEN + i * WE_STRIDE + WE_IN + (size_t)1184 * D * 2))[idx] = (u32x4){zv, zv, zv, zv};
    }
}
__device__ __forceinline__ void x_init(KArgP ap, int gw, int ngw, int lane) {
    unsigned char* ws = ap->ws;
    {
        const float* __restrict__ x = ap->in[0]; bf16_t* __restrict__ xb = (bf16_t*)(ws + WS_XB); float* __restrict__ ssq = (float*)(ws + WS_SSQ);
#pragma unroll 2
        for (int m = gw; m < S; m += ngw) {
            const f32x4* xr = (const f32x4*)(x + (size_t)m * D) + lane; float s = 0.f;
            u32x2* o8 = (u32x2*)(xb + (size_t)m * D) + lane;
#pragma unroll
            for (int j = 0; j < 4; ++j) { const f32x4 v = xr[64 * j]; s += (v[0] * v[0] + v[1] * v[1]) + (v[2] * v[2] + v[3] * v[3]); u32x2 w; w.x = cvt_pk_bf16(v[0], v[1]); w.y = cvt_pk_bf16(v[2], v[3]); o8[64 * j] = w; }
            s = wave_sum(s);
            if (lane < 16) ssq[(size_t)m * 16 + lane] = (lane == 0) ? s : 0.f;
        }
    }
}

__device__ __forceinline__ void convert_layer_half(KArgP ap, LAS unsigned char* lds, int Ln, int f, int w, int nw, int wave, int lane) {
    convert_items(ap, lds, Ln * I_LAYER + f * I_FFN, Ln * I_LAYER + (f + 1) * I_FFN, w, nw, wave, lane);
    if (f == 0) {
        const int i = Ln >> 1;
        if ((Ln & 1) == 0) { convert_items(ap, lds, I_ALLFFN + i * I_EVEN, I_ALLFFN + (i + 1) * I_EVEN, w, nw, wave, lane); fold_jobs(ap, lds, i, w, nw, wave, lane); }
        else convert_items(ap, lds, I_ALLFFN + 2 * I_EVEN + i * I_ODD, I_ALLFFN + 2 * I_EVEN + (i + 1) * I_ODD, w, nw, wave, lane);
    }
}
__device__ __forceinline__ void convert_chunk(KArgP ap, LAS unsigned char* lds, int k, int w, int nw, int wave, int lane) {
    if (k == 1) convert_items(ap, lds, 2 * I_FFN_M, I_LAYER, w, nw, wave, lane);
    else if (k <= 7) convert_layer_half(ap, lds, k >> 1, k & 1, w, nw, wave, lane);
}
__device__ __forceinline__ void prologue(KArgP ap, LAS unsigned char* lds, int gw, int ngw, int wave, int lane) {
    convert_items(ap, lds, 0, 2 * I_FFN_M, gw, ngw, wave, lane);
    convert_items(ap, lds, I_ALLFFN, I_ALLFFN + I_EVEN, gw, ngw, wave, lane);
    fold_jobs(ap, lds, 0, gw, ngw, wave, lane);
    x_init(ap, gw, ngw, lane);
}

__device__ __forceinline__ void pool_stats_phase(const bf16_t* __restrict__ Z, bf16_t* __restrict__ AO, float* __restrict__ RS, int gw, int ngw, int lane) {
    const int c0 = lane * 8, w = 2 << (lane >> 4);
#pragma unroll 2
    for (int t = gw; t < S; t += ngw) {
        const bf16_t* zr = Z + (size_t)t * ZW;
        const unsigned* pq = (const unsigned*)(zr + 512 + lane * 6); const unsigned qa = pq[0], qb = pq[1], qc = pq[2];
        const unsigned* pk = (const unsigned*)(zr + 896 + lane * 4); const unsigned ka = pk[0], kb = pk[1];
        u32x4 v[16];
#pragma unroll
        for (int j = 0; j < 16; ++j) { const int rr = (t - j) > 0 ? (t - j) : 0; v[j] = *(const u32x4*)(Z + (size_t)rr * ZW + c0); }
        { float s = bf_lo(qa) * bf_lo(qa) + bf_hi(qa) * bf_hi(qa) + bf_lo(qb) * bf_lo(qb) + bf_hi(qb) * bf_hi(qb) + bf_lo(qc) * bf_lo(qc) + bf_hi(qc) * bf_hi(qc);
          s = wave_sum(s); if (lane == 0) RS[(size_t)t * 2] = __builtin_amdgcn_rsqf(s * (1.0f / 384.0f) + EPS); }
        { float s = bf_lo(ka) * bf_lo(ka) + bf_hi(ka) * bf_hi(ka) + bf_lo(kb) * bf_lo(kb) + bf_hi(kb) * bf_hi(kb);
          s = wave_sum(s); if (lane == 0) RS[(size_t)t * 2 + 1] = __builtin_amdgcn_rsqf(s * (1.0f / 256.0f) + EPS); }
        float a0 = 0.f, a1 = 0.f, a2 = 0.f, a3 = 0.f, a4 = 0.f, a5 = 0.f, a6 = 0.f, a7 = 0.f;
#pragma unroll
        for (int j = 0; j < 16; ++j) {
            const float mk = (j < w && j <= t) ? 1.0f : 0.0f;
            a0 += mk * bf_lo(v[j].x); a1 += mk * bf_hi(v[j].x); a2 += mk * bf_lo(v[j].y); a3 += mk * bf_hi(v[j].y);
            a4 += mk * bf_lo(v[j].z); a5 += mk * bf_hi(v[j].z); a6 += mk * bf_lo(v[j].w); a7 += mk * bf_hi(v[j].w);
        }
        const float ic = 1.0f / (float)((t + 1 < w) ? (t + 1) : w);
        const u32x4 cur = v[0];
        u32x4 o; o.x = cvt_pk_bf16(a0 * ic - bf_lo(cur.x), a1 * ic - bf_hi(cur.x)); o.y = cvt_pk_bf16(a2 * ic - bf_lo(cur.y), a3 * ic - bf_hi(cur.y));
        o.z = cvt_pk_bf16(a4 * ic - bf_lo(cur.z), a5 * ic - bf_hi(cur.z)); o.w = cvt_pk_bf16(a6 * ic - bf_lo(cur.w), a7 * ic - bf_hi(cur.w));
        *(u32x4*)(AO + (size_t)t * D + c0) = o;
    }
}

__device__ __forceinline__ void qk_prep_phase(const bf16_t* __restrict__ QP, const bf16_t* __restrict__ KP, const bf16_t* __restrict__ Z, const float* __restrict__ qhn, const float* __restrict__ khn, bf16_t* __restrict__ Q, bf16_t* __restrict__ K, int gt, int ngt) {
    const float QSC = 0.10206207261596577f * 1.4426950408889634f;
    const int q4 = gt & 3;
    for (int item = gt >> 2; item < S * NH; item += ngt >> 2) {
        const int t = item >> 3, h = item & 7;
        u32x4 qv[3], kv[3];
        { const u32x4* p = (const u32x4*)(QP + (size_t)t * 768 + h * 96) + q4; qv[0] = p[0]; qv[1] = p[4]; qv[2] = p[8]; }
        { const u32x4* p = (const u32x4*)(KP + (size_t)t * 512 + h * 64) + q4; kv[0] = p[0]; kv[1] = p[4]; kv[2] = ((const u32x4*)(Z + (size_t)t * ZW + 1152))[q4]; }
        float cs[8], sn[8];
#pragma unroll
        for (int j = 0; j < 8; ++j) {
            const int i = 8 * (q4 & 1) + j;
            const float inv_freq = exp2f(-(float)i * (13.287712379549449f / 16.0f));
            const double rev = (double)t * (double)inv_freq * 0.15915494309189535;
            const float fr = (float)(rev - rint(rev));
            cs[j] = __builtin_amdgcn_cosf(fr); sn[j] = __builtin_amdgcn_sinf(fr);
        }
#pragma unroll
        for (int which = 0; which < 2; ++which) {
            const u32x4* v = which == 0 ? qv : kv; const float* gn = which == 0 ? qhn : khn;
            float ss = 0.f;
#pragma unroll
            for (int c = 0; c < 3; ++c) { const u32x4 x = v[c];
                ss += (bf_lo(x.x) * bf_lo(x.x) + bf_hi(x.x) * bf_hi(x.x)) + (bf_lo(x.y) * bf_lo(x.y) + bf_hi(x.y) * bf_hi(x.y)) + (bf_lo(x.z) * bf_lo(x.z) + bf_hi(x.z) * bf_hi(x.z)) + (bf_lo(x.w) * bf_lo(x.w) + bf_hi(x.w) * bf_hi(x.w)); }
            ss += shx(ss, 1); ss += shx(ss, 2);
            const float rs = __builtin_amdgcn_rsqf(ss * (1.0f / 96.0f) + EPS) * (which == 0 ? QSC : 1.0f);
            u32x4* dst = (u32x4*)((which == 0 ? Q : K) + ((size_t)h * S + t) * DQK) + q4;
#pragma unroll
            for (int c = 0; c < 2; ++c) {
                const u32x4 x = v[c]; const float* g = gn + 8 * q4 + 32 * c; const f32x4 g0 = *(const f32x4*)g, g1 = *(const f32x4*)(g + 4);
                u32x4 o; o.x = cvt_pk_bf16(bf_lo(x.x) * rs * g0[0], bf_hi(x.x) * rs * g0[1]); o.y = cvt_pk_bf16(bf_lo(x.y) * rs * g0[2], bf_hi(x.y) * rs * g0[3]);
                o.z = cvt_pk_bf16(bf_lo(x.z) * rs * g1[0], bf_hi(x.z) * rs * g1[1]); o.w = cvt_pk_bf16(bf_lo(x.w) * rs * g1[2], bf_hi(x.w) * rs * g1[3]);
                dst[4 * c] = o;
            }
            {
                const u32x4 xo = v[2];
                u32x4 xp; xp.x = shx(xo.x, 2); xp.y = shx(xo.y, 2); xp.z = shx(xo.z, 2); xp.w = shx(xo.w, 2);
                const float* go = gn + 64 + 8 * q4; const float* gp = gn + 64 + 8 * (q4 ^ 2);
                const f32x4 go0 = *(const f32x4*)go, go1 = *(const f32x4*)(go + 4), gp0 = *(const f32x4*)gp, gp1 = *(const f32x4*)(gp + 4);
                const float a[8] = {bf_lo(xo.x) * rs * go0[0], bf_hi(xo.x) * rs * go0[1], bf_lo(xo.y) * rs * go0[2], bf_hi(xo.y) * rs * go0[3], bf_lo(xo.z) * rs * go1[0], bf_hi(xo.z) * rs * go1[1], bf_lo(xo.w) * rs * go1[2], bf_hi(xo.w) * rs * go1[3]};
                const float b[8] = {bf_lo(xp.x) * rs * gp0[0], bf_hi(xp.x) * rs * gp0[1], bf_lo(xp.y) * rs * gp0[2], bf_hi(xp.y) * rs * gp0[3], bf_lo(xp.z) * rs * gp1[0], bf_hi(xp.z) * rs * gp1[1], bf_lo(xp.w) * rs * gp1[2], bf_hi(xp.w) * rs * gp1[3]};
                const float sg = (q4 < 2) ? -1.0f : 1.0f;
                float y[8];
#pragma unroll
                for (int j = 0; j < 8; ++j) y[j] = a[j] * cs[j] + sg * b[j] * sn[j];
                u32x4 o; o.x = cvt_pk_bf16(y[0], y[1]); o.y = cvt_pk_bf16(y[2], y[3]); o.z = cvt_pk_bf16(y[4], y[5]); o.w = cvt_pk_bf16(y[6], y[7]);
                dst[8] = o;
            }
        }
    }
}

__device__ __forceinline__ void conv_phase(const bf16_t* __restrict__ U, const bf16_t* __restrict__ GB, const float* __restrict__ cw, bf16_t* __restrict__ AO, int gt, int ngt) {
    const int c0 = (gt & 127) * 8;
    const f32x4 wa0 = *(const f32x4*)(cw + c0), wa1 = *(const f32x4*)(cw + c0 + 4);
    const f32x4 wb0 = *(const f32x4*)(cw + D + c0), wb1 = *(const f32x4*)(cw + D + c0 + 4);
    const f32x4 wc0 = *(const f32x4*)(cw + 2 * D + c0), wc1 = *(const f32x4*)(cw + 2 * D + c0 + 4);
#pragma unroll 4
    for (int idx = gt; idx < S * 128; idx += ngt) {
        const int t = idx >> 7;
        const int t1 = t >= 1 ? t - 1 : 0, t2 = t >= 2 ? t - 2 : 0;
        const float m1 = t >= 1 ? 1.0f : 0.0f, m2 = t >= 2 ? 1.0f : 0.0f;
        const u32x4 u0 = *(const u32x4*)(U + (size_t)t * D + c0);
        const u32x4 u1 = *(const u32x4*)(U + (size_t)t1 * D + c0);
        const u32x4 u2 = *(const u32x4*)(U + (size_t)t2 * D + c0);
        const u32x4 gb = *(const u32x4*)(GB + (size_t)t * D + c0);
        float y[8];
        y[0] = m2 * wa0[0] * bf_lo(u2.x) + m1 * wb0[0] * bf_lo(u1.x) + wc0[0] * bf_lo(u0.x);
        y[1] = m2 * wa0[1] * bf_hi(u2.x) + m1 * wb0[1] * bf_hi(u1.x) + wc0[1] * bf_hi(u0.x);
        y[2] = m2 * wa0[2] * bf_lo(u2.y) + m1 * wb0[2] * bf_lo(u1.y) + wc0[2] * bf_lo(u0.y);
        y[3] = m2 * wa0[3] * bf_hi(u2.y) + m1 * wb0[3] * bf_hi(u1.y) + wc0[3] * bf_hi(u0.y);
        y[4] = m2 * wa1[0] * bf_lo(u2.z) + m1 * wb1[0] * bf_lo(u1.z) + wc1[0] * bf_lo(u0.z);
        y[5] = m2 * wa1[1] * bf_hi(u2.z) + m1 * wb1[1] * bf_hi(u1.z) + wc1[1] * bf_hi(u0.z);
        y[6] = m2 * wa1[2] * bf_lo(u2.w) + m1 * wb1[2] * bf_lo(u1.w) + wc1[2] * bf_lo(u0.w);
        y[7] = m2 * wa1[3] * bf_hi(u2.w) + m1 * wb1[3] * bf_hi(u1.w) + wc1[3] * bf_hi(u0.w);
        u32x4 o; o.x = cvt_pk_bf16(bf_lo(gb.x) * y[0], bf_hi(gb.x) * y[1]); o.y = cvt_pk_bf16(bf_lo(gb.y) * y[2], bf_hi(gb.y) * y[3]);
        o.z = cvt_pk_bf16(bf_lo(gb.z) * y[4], bf_hi(gb.z) * y[5]); o.w = cvt_pk_bf16(bf_lo(gb.w) * y[6], bf_hi(gb.w) * y[7]);
        *(u32x4*)(AO + (size_t)t * D + c0) = o;
    }
}

struct Ids { int lane, wave, vcu, gw, ngw, gt, ngt, G, bx; };
__device__ __forceinline__ Ids make_ids(LAS unsigned char* lds) {
    Ids d; d.wave = wave_index(lds); int tid = d.wave * 64 + lane_id(); asm volatile("" : "+v"(tid));
    d.lane = tid & 63;
    d.G = gridDim.x; d.bx = blockIdx.x; asm volatile("" : "+s"(d.G), "+s"(d.bx));
    d.vcu = (d.G % 8 == 0) ? (d.bx % 8) * (d.G / 8) + d.bx / 8 : d.bx;
    d.gw = d.vcu * 8 + d.wave; d.ngw = d.G * 8; d.gt = d.gw * 64 + d.lane; d.ngt = d.ngw * 64;
    return d;
}

__global__ void __launch_bounds__(512, 2) fwd_megakernel(Args a_unused) {
    extern __shared__ __attribute__((aligned(16))) unsigned char lds_raw[];
    LAS unsigned char* lds = (LAS unsigned char*)lds_raw;

    {
        const int w_ = __builtin_amdgcn_readfirstlane((int)threadIdx.x >> 6);
        if (lane_id() == 0) ((volatile LAS int*)(lds + WTAB_OFF))[hw_slot()] = w_;
        if (w_ == 0 && lane_id() < 2) ((volatile LAS unsigned*)(lds + MISC_OFF))[lane_id()] = 0u;
    }
    __syncthreads();
    (void)xcd_barrier_post((unsigned*)(KARGS()->ws + WS_CTL), (volatile LAS unsigned*)(lds + MISC_OFF), wave_index(lds) == 0 && lane_id() == 0);
    { const Ids d = make_ids(lds); KArgP k = KARGS();
      for (int rep = 0; rep < PROBE_PRO_REPS; ++rep) prologue(k, lds, d.gw, d.ngw, d.wave, d.lane); }
    if (a_unused.ws == nullptr) cg::this_grid().sync();
    GSYNC();

#pragma unroll 1
    for (int L = 0; L < DEPTH; ++L) {
#pragma unroll 1
        for (int f = 0; f < 2; ++f) {
            {
                KArgP k = KARGS(); unsigned char* ws = k->ws;
                const bf16_t* wgu = (const bf16_t*)(ws + WS_W + L * W_FFN_LAYER + f * (W_GU_BYTES + W_DN_BYTES));
                pg8::Gemm g{(const bf16_t*)(ws + WS_XB), wgu, S, 2 * FF, D, D, D}; pg8::StaticOrder so; so.init(S, 2 * FF, gridDim.x, blockIdx.x);
                pg8::EpiSwiGLU E{(bf16_t*)(ws + WS_H), (const float*)(ws + WS_SSQ), lds};
                for (int rep = 0; rep < PROBE_GU_REPS; ++rep) pg8::gemm_phase<pg8::EpiSwiGLU>(lds, g, so, E);
                {
                    const Ids d = make_ids(lds); const int half = d.G / 2;
                    if (d.bx >= half) convert_chunk(KARGS(), lds, 2 * L + f + 1, (d.bx - half) * 8 + d.wave, (d.G - half) * 8, d.wave, d.lane);
                }
            }
            GSYNC();
            {
                KArgP k = KARGS(); unsigned char* ws = k->ws; float* out = k->out;
                const bf16_t* wdn = (const bf16_t*)(ws + WS_W + L * W_FFN_LAYER + f * (W_GU_BYTES + W_DN_BYTES) + W_GU_BYTES);
                pg8::Gemm g{(const bf16_t*)(ws + WS_H), wdn, S, D, FF, FF, FF}; pg8::StaticOrder so; so.init(S, D, gridDim.x, blockIdx.x);
                pg8::EpiResid E{(L == DEPTH - 1 && f == 1) ? out : (float*)nullptr, (bf16_t*)(ws + WS_XB), (float*)(ws + WS_SSQ), 0.5f};
                pg8::gemm_phase<pg8::EpiResid>(lds, g, so, E);
#ifdef PROBE_DN
                { GSYNC(); pg8::EpiResid E2{(float*)nullptr, (bf16_t*)(ws + WS_XB), (float*)(ws + WS_SSQ), 0.0f}; pg8::gemm_phase<pg8::EpiResid>(lds, g, so, E2); }
#endif
            }
            GSYNC();
            if (f == 1) break;
            const int i = L >> 1;
            if ((L & 1) == 0) {
                {
                    KArgP k = KARGS(); unsigned char* ws = k->ws; unsigned char* wb = ws + WS_WEVEN + i * WE_STRIDE;
                    pg8::Gemm g{(const bf16_t*)(ws + WS_XB), (const bf16_t*)(wb + WE_IN), S, ZW, D, D, D}; pg8::StaticOrder so; so.init(S, ZW, gridDim.x, blockIdx.x);
                    pg8::EpiRowBf16<0> E{(bf16_t*)(ws + WS_Z), ZW, (const float*)(ws + WS_SSQ), 0, lds};
                    for (int rep_ = 0; rep_ < PROBE_MIXA_REPS; ++rep_) pg8::gemm_phase<pg8::EpiRowBf16<0>>(lds, g, so, E);
                }
                GSYNC();
                { KArgP k = KARGS(); unsigned char* ws = k->ws; const Ids d = make_ids(lds);
                  for (int rep = 0; rep < PROBE_EWA_REPS; ++rep) pool_stats_phase((const bf16_t*)(ws + WS_Z), (bf16_t*)(ws + WS_AO), (float*)(ws + WS_RS), d.gw, d.ngw, d.lane); }
                GSYNC();
                {
                    KArgP k = KARGS(); unsigned char* ws = k->ws; unsigned char* wb = ws + WS_WEVEN + i * WE_STRIDE;
                    pg8::Gemm g{(const bf16_t*)(ws + WS_Z) + 512, (const bf16_t*)(wb + WE_Q), S, 768, 384, ZW, 384}; pg8::StaticOrder so; so.init(S, 768, gridDim.x, blockIdx.x);
                    pg8::EpiRowBf16<1> E{(bf16_t*)(ws + WS_QP), 768, (const float*)(ws + WS_RS), 0, lds};
                    for (int rep_ = 0; rep_ < PROBE_MIXB_REPS; ++rep_) pg8::gemm_phase<pg8::EpiRowBf16<1>>(lds, g, so, E);
                }
                {
                    KArgP k = KARGS(); unsigned char* ws = k->ws; unsigned char* wb = ws + WS_WEVEN + i * WE_STRIDE;
                    pg8::Gemm g{(const bf16_t*)(ws + WS_Z) + 896, (const bf16_t*)(wb + WE_K), S, 512, 256, ZW, 256}; pg8::StaticOrder so; so.init(S, 512, gridDim.x, (blockIdx.x + gridDim.x / 2) % gridDim.x);
                    pg8::EpiRowBf16<1> E{(bf16_t*)(ws + WS_KP), 512, (const float*)(ws + WS_RS), 1, lds};
                    for (int rep_ = 0; rep_ < PROBE_MIXB_REPS; ++rep_) pg8::gemm_phase<pg8::EpiRowBf16<1>>(lds, g, so, E);
                }
                {
                    KArgP k = KARGS(); unsigned char* ws = k->ws; unsigned char* wb = ws + WS_WEVEN + i * WE_STRIDE;
                    pg8::Gemm g{(const bf16_t*)(wb + WE_V), (const bf16_t*)(ws + WS_Z) + 896, 512, S, 256, 256, ZW}; pg8::StaticOrder so; so.init(512, S, gridDim.x, (blockIdx.x + 3 * gridDim.x / 4) % gridDim.x);
                    pg8::EpiColBf16 E{(bf16_t*)(ws + WS_VT), S, (const float*)(ws + WS_RS)};
                    for (int rep_ = 0; rep_ < PROBE_MIXB_REPS; ++rep_) pg8::gemm_phase<pg8::EpiColBf16>(lds, g, so, E);
                }
                GSYNC();
                { KArgP k = KARGS(); unsigned char* ws = k->ws; const Ids d = make_ids(lds);
                  for (int rep = 0; rep < PROBE_EWB_REPS; ++rep) qk_prep_phase((const bf16_t*)(ws + WS_QP), (const bf16_t*)(ws + WS_KP), (const bf16_t*)(ws + WS_Z), k->in[15] + (size_t)i * DQK, k->in[16] + (size_t)i * DQK,
                                (bf16_t*)(ws + WS_Q), (bf16_t*)(ws + WS_K), d.gt, d.ngt); }
                GSYNC();
                {
                    KArgP k = KARGS(); unsigned char* ws = k->ws; const Ids d = make_ids(lds);
                    const int h = (d.vcu >> 5) & 7, s = d.vcu & 31;
#ifndef PROBE_ATT_REPS
#define PROBE_ATT_REPS 1
#endif
                    if (d.vcu < 256) for (int rep = 0; rep < PROBE_ATT_REPS; ++rep) {
                        att::attn_unit<0>(h, 63 - s, (const bf16_t*)(ws + WS_Q), (const bf16_t*)(ws + WS_K), (const bf16_t*)(ws + WS_VT), (bf16_t*)(ws + WS_AO), lds);
                        att::attn_unit<0>(h, s, (const bf16_t*)(ws + WS_Q), (const bf16_t*)(ws + WS_K), (const bf16_t*)(ws + WS_VT), (bf16_t*)(ws + WS_AO), lds);
                    }
#ifdef PROBE_ATT_VAR
                    if (d.vcu < 256) {
                        att::attn_unit<PROBE_ATT_VAR>(h, 63 - s, (const bf16_t*)(ws + WS_Q), (const bf16_t*)(ws + WS_K), (const bf16_t*)(ws + WS_VT), (bf16_t*)(ws + WS_QP), lds);
                        att::attn_unit<PROBE_ATT_VAR>(h, s, (const bf16_t*)(ws + WS_Q), (const bf16_t*)(ws + WS_K), (const bf16_t*)(ws + WS_VT), (bf16_t*)(ws + WS_QP), lds);
                    }
#endif
                }
                GSYNC();
                {
                    KArgP k = KARGS(); unsigned char* ws = k->ws; float* out = k->out; unsigned char* wb = ws + WS_WEVEN + i * WE_STRIDE;
                    pg8::Gemm g{(const bf16_t*)(ws + WS_AO), (const bf16_t*)(wb + WE_OUT), S, D, D, D, D}; pg8::StaticOrder so; so.init(S, D, gridDim.x, blockIdx.x);
                    pg8::EpiResid E{(float*)nullptr, (bf16_t*)(ws + WS_XB), (float*)(ws + WS_SSQ), 1.0f};
                    pg8::gemm_phase<pg8::EpiResid>(lds, g, so, E);
#ifdef PROBE_MIXOUT
                    { pg8::EpiResid E2{(float*)nullptr, (bf16_t*)(ws + WS_XB), (float*)(ws + WS_SSQ), 0.0f}; pg8::gemm_phase<pg8::EpiResid>(lds, g, so, E2); }
#endif
                }
                GSYNC();
            } else {
                {
                    KArgP k = KARGS(); unsigned char* ws = k->ws; unsigned char* wb = ws + WS_WODD + i * WO_STRIDE;
                    pg8::Gemm g{(const bf16_t*)(ws + WS_XB), (const bf16_t*)(wb + WO_IN), S, 3 * D, D, D, D}; pg8::StaticOrder so; so.init(S, 3 * D, gridDim.x, blockIdx.x);
                    pg8::EpiConvIn E{(bf16_t*)(ws + WS_U), (bf16_t*)(ws + WS_GB), (const float*)(ws + WS_SSQ), lds};
                    for (int rep_ = 0; rep_ < PROBE_MIXC_REPS; ++rep_) pg8::gemm_phase<pg8::EpiConvIn>(lds, g, so, E);
                }
                GSYNC();
                { KArgP k = KARGS(); unsigned char* ws = k->ws; const Ids d = make_ids(lds);
                  for (int rep = 0; rep < PROBE_EWC_REPS; ++rep) conv_phase((const bf16_t*)(ws + WS_U), (const bf16_t*)(ws + WS_GB), k->in[21] + (size_t)i * 3 * D, (bf16_t*)(ws + WS_AO), d.gt, d.ngt); }
                GSYNC();
                {
                    KArgP k = KARGS(); unsigned char* ws = k->ws; float* out = k->out; unsigned char* wb = ws + WS_WODD + i * WO_STRIDE;
                    pg8::Gemm g{(const bf16_t*)(ws + WS_AO), (const bf16_t*)(wb + WO_OUT), S, D, D, D, D}; pg8::StaticOrder so; so.init(S, D, gridDim.x, blockIdx.x);
                    pg8::EpiResid E{(float*)nullptr, (bf16_t*)(ws + WS_XB), (float*)(ws + WS_SSQ), 1.0f};
                    pg8::gemm_phase<pg8::EpiResid>(lds, g, so, E);
#ifdef PROBE_MIXOUT
                    { pg8::EpiResid E2{(float*)nullptr, (bf16_t*)(ws + WS_XB), (float*)(ws + WS_SSQ), 0.0f}; pg8::gemm_phase<pg8::EpiResid>(lds, g, so, E2); }
#endif
                }
                GSYNC();
            }
        }
    }
}

extern "C" void kernel_launch(void* const* d_in, const int* in_sizes, int n_in, void* d_out, int out_size, void* d_ws, size_t ws_size, hipStream_t stream) {
    static int grid = 0;
    if (grid == 0) {
        if (n_in != 23 || out_size != S * D || ws_size < WS_END) { fprintf(stderr, "kernel_launch: unexpected shapes (n_in %d out %d ws %zu need %zu)\n", n_in, out_size, ws_size, (size_t)WS_END); grid = -1; return; }
        int dev = 0, cus = 0, per_cu = 0;
        hipGetDevice(&dev);
        hipDeviceGetAttribute(&cus, hipDeviceAttributeMultiprocessorCount, dev);
        if (hipFuncSetAttribute((const void*)fwd_megakernel, hipFuncAttributeMaxDynamicSharedMemorySize, LDS_BYTES) != hipSuccess) { fprintf(stderr, "hipFuncSetAttribute failed\n"); grid = -1; return; }
        hipOccupancyMaxActiveBlocksPerMultiprocessor(&per_cu, (const void*)fwd_megakernel, 512, LDS_BYTES);
        (void)hipGetLastError();
        if (per_cu < 1) per_cu = 1;
        grid = cus;
        if (grid > 256) grid = 256;
    }
    if (grid < 0) return;
    if (hipMemsetAsync((char*)d_ws + WS_CTL, 0, CTL_BYTES, stream) != hipSuccess) { fprintf(stderr, "memset failed\n"); return; }
    Args a{};
    for (int i = 0; i < 23; ++i) a.in[i] = (const float*)d_in[i];
    a.out = (float*)d_out; a.ws = (unsigned char*)d_ws;
    void* args[] = {&a};
    hipError_t e = hipLaunchCooperativeKernel((const void*)fwd_megakernel, dim3(grid), dim3(512), args, LDS_BYTES, stream);
    if (e != hipSuccess) fprintf(stderr, "cooperative launch failed: %s (grid %d)\n", hipGetErrorString(e), grid);
}
```
